# Optimizing an MI355X kernel written in HIP

```python
import jax, jax.numpy as jnp
from jax import lax
import numpy as np

D_MODEL = 1024
BATCH = 8
SEQ = 4096
DEPTH = 2

CHUNK = 64
N_MIXERS = 2
N_RET = (DEPTH + 1) // 2
N_MLA = DEPTH // 2
ROPE_THETA = 10000.0
EPS = 1e-6
RET_HEADS = 4
RET_DK = D_MODEL // RET_HEADS
RET_DV = 2 * RET_DK
RET_QK_W = RET_HEADS * RET_DK
RET_V_W = RET_HEADS * RET_DV
RET_IN = 2 * RET_QK_W + 2 * RET_V_W
MLA_HEADS = 8
MLA_NOPE = 128
MLA_ROPE = 64
MLA_QKD = MLA_NOPE + MLA_ROPE
MLA_VD = 128
MLA_Q_RANK = 384
MLA_KV_RANK = 256
MLA_IN = MLA_Q_RANK + MLA_KV_RANK + MLA_ROPE
Q_BLOCK = 128
D_FF = 4 * D_MODEL
PLE_DIM = 256

kernel_name = "hybrid_retention_mla_trunk"


def _rmsnorm(x, g):
    xf = x.astype(jnp.float32)
    y = xf * lax.rsqrt(jnp.mean(xf * xf, axis=-1, keepdims=True) + EPS)
    return (y * g.astype(jnp.float32)).astype(x.dtype)


def _rope_tables(seq, dim, dtype):
    inv = 1.0 / (ROPE_THETA ** (jnp.arange(0, dim, 2, dtype=jnp.float32) / dim))
    ang = jnp.arange(seq, dtype=jnp.float32)[:, None] * inv[None, :]
    return jnp.cos(ang)[:, None, :].astype(dtype), jnp.sin(ang)[:, None, :].astype(dtype)


def _rope(x, cos, sin):
    x1, x2 = jnp.split(x, 2, axis=-1)
    return jnp.concatenate([x1 * cos - x2 * sin, x2 * cos + x1 * sin], axis=-1)


def _retention(h, w_in, gn_gain, w_out):
    B, S, _ = h.shape
    nc = S // CHUNK
    proj = h @ w_in
    q, k, v, g = jnp.split(proj, [RET_QK_W, 2 * RET_QK_W, 2 * RET_QK_W + RET_V_W], axis=-1)
    cos, sin = _rope_tables(S, RET_DK, h.dtype)
    q = _rope(q.reshape(B, S, RET_HEADS, RET_DK), cos, sin)
    k = _rope(k.reshape(B, S, RET_HEADS, RET_DK), cos, sin) * (RET_DK ** -0.5)
    v = v.reshape(B, S, RET_HEADS, RET_DV)

    def to_chunks(t):
        return t.reshape(B, nc, CHUNK, RET_HEADS, t.shape[-1]).transpose(1, 0, 3, 2, 4)

    qc, kc, vc = to_chunks(q), to_chunks(k), to_chunks(v)
    log_gamma = jnp.log(1.0 - 2.0 ** (-5.0 - jnp.arange(RET_HEADS, dtype=jnp.float32)))
    idx = jnp.arange(CHUNK, dtype=jnp.float32)
    dist = jnp.abs(idx[:, None] - idx[None, :])
    intra = jnp.exp(log_gamma[:, None, None] * dist).astype(h.dtype)
    q_decay = jnp.exp(log_gamma[:, None] * (idx + 1.0))[None, :, :, None].astype(h.dtype)
    k_decay = jnp.exp(log_gamma[:, None] * (CHUNK - 1.0 - idx))[None, :, :, None].astype(h.dtype)
    chunk_decay = jnp.exp(log_gamma * CHUNK)[None, :, None, None].astype(h.dtype)

    def step(state, xs):
        qi, ki, vi = xs
        scores = jnp.einsum('bhnd,bhmd->bhnm', qi, ki) * intra
        inner = jnp.einsum('bhnm,bhmv->bhnv', scores, vi)
        cross = jnp.einsum('bhnd,bhdv->bhnv', qi * q_decay, state)
        new_state = state * chunk_decay + jnp.einsum('bhmd,bhmv->bhdv', ki * k_decay, vi)
        return new_state, inner + cross

    state0 = jnp.zeros((B, RET_HEADS, RET_DK, RET_DV), h.dtype)
    _, out = lax.scan(step, state0, (qc, kc, vc))
    out = out.transpose(1, 0, 3, 2, 4).reshape(B, S, RET_HEADS, RET_DV)
    out = _rmsnorm(out, gn_gain).reshape(B, S, RET_V_W)
    return (jax.nn.silu(g) * out) @ w_out


def _mla(h, w_in, q_a_gain, kv_a_gain, w_uq, w_ukv, q_gain, k_gain, w_out):
    B, S, _ = h.shape
    proj = h @ w_in
    c_q, c_kv, k_r = jnp.split(proj, [MLA_Q_RANK, MLA_Q_RANK + MLA_KV_RANK], axis=-1)
    q = (_rmsnorm(c_q, q_a_gain) @ w_uq).reshape(B, S, MLA_HEADS, MLA_QKD)
    kv = (_rmsnorm(c_kv, kv_a_gain) @ w_ukv).reshape(B, S, MLA_HEADS, MLA_NOPE + MLA_VD)
    k_nope, v = jnp.split(kv, [MLA_NOPE], axis=-1)
    k = jnp.concatenate([k_nope, jnp.broadcast_to(k_r[:, :, None, :], (B, S, MLA_HEADS, MLA_ROPE))], axis=-1)
    q = _rmsnorm(q, q_gain)
    k = _rmsnorm(k, k_gain)
    cos, sin = _rope_tables(S, MLA_ROPE, h.dtype)
    q = jnp.concatenate([q[..., :MLA_NOPE], _rope(q[..., MLA_NOPE:], cos, sin)], axis=-1)
    k = jnp.concatenate([k[..., :MLA_NOPE], _rope(k[..., MLA_NOPE:], cos, sin)], axis=-1)
    q = q.transpose(0, 2, 1, 3)
    k = k.transpose(0, 2, 1, 3)
    v = v.transpose(0, 2, 1, 3)
    scale = MLA_QKD ** -0.5
    outs = []
    for blk in range(S // Q_BLOCK):
        q0 = blk * Q_BLOCK
        kend = q0 + Q_BLOCK
        qb = q[:, :, q0:kend]
        kb = k[:, :, :kend]
        vb = v[:, :, :kend]
        s = jnp.einsum('bhqd,bhkd->bhqk', qb, kb).astype(jnp.float32) * scale
        q_chunk = (q0 + jnp.arange(Q_BLOCK)) // CHUNK
        k_chunk = jnp.arange(kend) // CHUNK
        s = jnp.where(k_chunk[None, :] <= q_chunk[:, None], s, -1e30)
        pr = jax.nn.softmax(s, axis=-1).astype(vb.dtype)
        outs.append(jnp.einsum('bhqk,bhkd->bhqd', pr, vb))
    o = jnp.concatenate(outs, axis=2).transpose(0, 2, 1, 3).reshape(B, S, MLA_HEADS * MLA_VD)
    return o @ w_out


def _dense(k, shape, fan_in):
    return jax.random.normal(k, shape, jnp.float32) * (fan_in ** -0.5)


def _gain(k, shape):
    return 1.0 + 0.05 * jax.random.normal(k, shape, jnp.float32)


def setup_inputs(seed: int = 0) -> dict:
    key = jax.random.key(seed)
    ks = jax.random.split(key, 20)
    return {
        "x": jax.random.normal(ks[0], (BATCH, SEQ, D_MODEL), jnp.float32),
        "p": jax.random.normal(ks[1], (DEPTH, BATCH, SEQ, PLE_DIM), jnp.float32),
        "mix_norm": _gain(ks[2], (DEPTH, D_MODEL)),
        "ret_w_in": _dense(ks[3], (N_RET, D_MODEL, RET_IN), D_MODEL),
        "ret_gn": _gain(ks[4], (N_RET, RET_HEADS, RET_DV)),
        "ret_w_out": _dense(ks[5], (N_RET, RET_V_W, D_MODEL), RET_V_W),
        "mla_w_in": _dense(ks[6], (N_MLA, D_MODEL, MLA_IN), D_MODEL),
        "mla_q_a_norm": _gain(ks[7], (N_MLA, MLA_Q_RANK)),
        "mla_kv_a_norm": _gain(ks[8], (N_MLA, MLA_KV_RANK)),
        "mla_w_uq": _dense(ks[9], (N_MLA, MLA_Q_RANK, MLA_HEADS * MLA_QKD), MLA_Q_RANK),
        "mla_w_ukv": _dense(ks[10], (N_MLA, MLA_KV_RANK, MLA_HEADS * (MLA_NOPE + MLA_VD)), MLA_KV_RANK),
        "mla_q_norm": _gain(ks[11], (N_MLA, MLA_QKD)),
        "mla_k_norm": _gain(ks[12], (N_MLA, MLA_QKD)),
        "mla_w_out": _dense(ks[13], (N_MLA, MLA_HEADS * MLA_VD, D_MODEL), MLA_HEADS * MLA_VD),
        "mlp_norm": _gain(ks[14], (DEPTH, D_MODEL)),
        "mlp_w1": _dense(ks[15], (DEPTH, D_MODEL, D_FF), D_MODEL),
        "mlp_w2": _dense(ks[16], (DEPTH, D_FF, D_MODEL), D_FF),
        "ple_norm": _gain(ks[17], (DEPTH, D_MODEL)),
        "ple_gate_w": _dense(ks[18], (DEPTH, D_MODEL, D_MODEL), D_MODEL),
        "ple_proj_w": _dense(ks[19], (DEPTH, PLE_DIM, D_MODEL), PLE_DIM),
    }


def reference(x, p, mix_norm, ret_w_in, ret_gn, ret_w_out, mla_w_in, mla_q_a_norm, mla_kv_a_norm,
              mla_w_uq, mla_w_ukv, mla_q_norm, mla_k_norm, mla_w_out, mlp_norm, mlp_w1, mlp_w2,
              ple_norm, ple_gate_w, ple_proj_w):
    h = x
    for i in range(DEPTH):
        j = i // N_MIXERS
        hn = _rmsnorm(h, mix_norm[i])
        if i % N_MIXERS == 0:
            mixed = _retention(hn, ret_w_in[j], ret_gn[j], ret_w_out[j])
        else:
            mixed = _mla(hn, mla_w_in[j], mla_q_a_norm[j], mla_kv_a_norm[j], mla_w_uq[j], mla_w_ukv[j],
                         mla_q_norm[j], mla_k_norm[j], mla_w_out[j])
        h = h + mixed
        hn = _rmsnorm(h, mlp_norm[i])
        h = h + jnp.square(jax.nn.relu(hn @ mlp_w1[i])) @ mlp_w2[i]
        gate = jax.nn.sigmoid(_rmsnorm(h, ple_norm[i]) @ ple_gate_w[i])
        h = h + gate * (p[i] @ ple_proj_w[i])
    return h
```

```cpp
#include <hip/hip_runtime.h>
#include <hip/hip_cooperative_groups.h>
#include <cstdio>
#include <cstdint>
namespace cg = cooperative_groups;

#define LAS __attribute__((address_space(3)))
typedef unsigned short bf16_t;
typedef short bf16x8 __attribute__((ext_vector_type(8)));
typedef float f32x4 __attribute__((ext_vector_type(4)));
typedef float f32x2 __attribute__((ext_vector_type(2)));
typedef unsigned u32x4 __attribute__((ext_vector_type(4)));
typedef unsigned u32x2 __attribute__((ext_vector_type(2)));


constexpr int MT = 32768, SEQ = 4096, DM = 1024, FF = 4096, PLE = 256;
constexpr float EPS = 1e-6f;
constexpr int NTHREADS = 512, NWAVES = 8;
constexpr int LDS_BYTES = 160 * 1024;

constexpr size_t MiB = 1u << 20;
constexpr size_t WS_SSQ = 0;
constexpr size_t WS_RSSQ = 496 * MiB;
constexpr size_t WS_ROPE_R = 5 * MiB;
constexpr size_t WS_ROPE_M = 9 * MiB;
constexpr size_t WS_SMALL = 10 * MiB;
constexpr size_t WS_BAR = 12 * MiB;
constexpr size_t WS_W = 16 * MiB;
constexpr size_t WS_PB = 80 * MiB;
constexpr size_t WS_HBA = 112 * MiB;
constexpr size_t WS_R = 176 * MiB;
constexpr size_t WS_END = 512 * MiB;
constexpr size_t R_QK = 0;
constexpr size_t R_V = 128 * MiB;
constexpr size_t R_HID = 0;
constexpr size_t R_PP = 160 * MiB;
constexpr size_t R_HBB = 64 * MiB;
constexpr size_t R_CQKV = 0;
constexpr size_t R_O = 0;
constexpr size_t R_Q = 64 * MiB;
constexpr size_t R_KV = 160 * MiB;
constexpr size_t W_RIN = 0, W_ROUT = 6291456, W_MIN = 8388608, W_UQ = 9175040, W_UKV = 9764864, W_MOUT = 10420224,
                 W_1 = 11468800, W_2 = 19857408, W_G = 28246016, W_P = 30343168;
enum { SQ_MIX0 = 0, SQ_MLP0, SQ_PLE0, SQ_MIX1, SQ_MLP1, SQ_PLE1, SQ_CQ, SQ_CKV };

struct Params {
    const float* in[20];
    float* out;
    unsigned char* ws;
};

__device__ __forceinline__ unsigned f2bf(float f) { unsigned u = __builtin_bit_cast(unsigned, f); return (u + 0x7fffu + ((u >> 16) & 1u)) >> 16; }
typedef __bf16 bf16x2_t __attribute__((ext_vector_type(2)));
__device__ __forceinline__ unsigned cvt_pk_bf16(float lo, float hi) { f32x2 v = {lo, hi}; bf16x2_t b = __builtin_convertvector(v, bf16x2_t); return __builtin_bit_cast(unsigned, b); }
__device__ __forceinline__ unsigned pk2(float lo, float hi) { return cvt_pk_bf16(lo, hi); }
__device__ __forceinline__ float bf2f(unsigned short b) { return __builtin_bit_cast(float, (unsigned)b << 16); }
__device__ __forceinline__ float bflo(unsigned w) { return __builtin_bit_cast(float, w << 16); }
__device__ __forceinline__ float bfhi(unsigned w) { return __builtin_bit_cast(float, w & 0xffff0000u); }
__device__ __forceinline__ int lane_id_asm() { int l; asm volatile("v_mbcnt_lo_u32_b32 %0, -1, 0\n\tv_mbcnt_hi_u32_b32 %0, -1, %0" : "=v"(l)); return l; }
__device__ __forceinline__ float wave_sum(float v) {
#pragma unroll
    for (int o = 1; o < 64; o <<= 1) v += __shfl_xor(v, o);
    return v;
}
__device__ __forceinline__ float wave_max(float v) {
#pragma unroll
    for (int o = 1; o < 64; o <<= 1) v = fmaxf(v, __shfl_xor(v, o));
    return v;
}

namespace pg8 {
constexpr int BM = 256, BK = 64, HALF = 128, HTB = HALF * BK * 2, STAGE_BYTES = 8 * HTB, NXCD = 8, WGM = 4;
__device__ __forceinline__ int lds_byte(int r, int c) { const int st = (r >> 4) * 2 + (c >> 5), rr = r & 15, cc = c & 31, ob = rr * 64 + cc * 2; return st * 1024 + (ob ^ (((ob >> 9) & 1) << 5)); }
__device__ __forceinline__ void stage_rc(int b, int& R, int& C) { const int st = b / 1024, sb = b % 1024, swz = sb ^ (((sb >> 9) & 1) << 5); R = (st >> 1) * 16 + swz / 64; C = (st & 1) * 32 + (swz % 64) / 2; }
__device__ __forceinline__ int perm32(int rho) { const int n = rho >> 4, i = rho & 15; return 8 * (i >> 2) + 4 * n + (i & 3); }

struct Unit { int pm, pn; };
struct Gemm { const bf16_t* A; const bf16_t* Bt; int M, N, K, lda; };

struct StaticOrder {
    int nM, nN, nwg, G, c;
    __device__ void init(int M, int N, int G_, int c_) { nM = M / BM; nN = N / BM; nwg = nM * nN; G = G_; c = c_; }
    __device__ bool next(int i, Unit& u) const {
        const long L = (long)i * G + c; if (L >= nwg) return false;
        int wgid = (int)L; { const int q = nwg / NXCD, r = nwg % NXCD, xcd = wgid % NXCD, off = wgid / NXCD; wgid = (xcd < r ? xcd * (q + 1) : r * (q + 1) + (xcd - r) * q) + off; }
        const int nig = WGM * nN, gid = wgid / nig, fm = gid * WGM, gsz = (nM - fm) < WGM ? (nM - fm) : WGM;
        u.pm = fm + ((wgid % nig) % gsz); u.pn = (wgid % nig) / gsz; return true;
    }
};

template <class Epi>
__device__ __forceinline__ void gemm_phase(LAS unsigned char* lds, const Gemm g, const StaticOrder& S, const Epi& E, const int wid) {
    const int lane = lane_id_asm(), tid = wid * 64 + lane, wr = wid >> 2, wc = wid & 3, fr = lane & 15, fq = lane >> 4;
    const int K = g.K, nt = K / BK, lda = g.lda;
    unsigned voffA[2], voffB[2];
#pragma unroll
    for (int i = 0; i < 2; ++i) { int R, C; stage_rc(tid * 16 + i * 8192, R, C); const int Rb = Epi::PERM ? ((R & ~31) + perm32(R & 31)) : R;
        voffA[i] = (unsigned)(R * lda + C) * 2u; voffB[i] = (unsigned)(Rb * K + C) * 2u; }
    const size_t kstep = (size_t)(BK * 2);
    const size_t hsA = (size_t)HALF * lda * 2, hsB = (size_t)HALF * K * 2;
    const size_t tsA = 2 * hsA, tsB = 2 * hsB;
    const unsigned ldsw = (unsigned)wid * 1024u;
    const int aoff = lds_byte(wr * 64 + fr, fq * 8), boff = lds_byte(wc * 32 + fr, fq * 8);
#define PG8_SA(b, h) (((b) * 2 + (h)) * HTB)
#define PG8_SB(b, h) ((4 + (b) * 2 + (h)) * HTB)
#define PG8_STAGE(bufoff, gbase, voff) do { _Pragma("unroll") for (int _i = 0; _i < 2; ++_i) \
        __builtin_amdgcn_global_load_lds((const unsigned*)((const char*)(gbase) + (voff)[_i]), (LAS unsigned*)(lds + (bufoff) + ldsw + _i * 8192), 16, 0, 0); } while (0)
#define PG8_LDA(dst, b, h) do { _Pragma("unroll") for (int m = 0; m < 4; ++m) _Pragma("unroll") for (int k = 0; k < 2; ++k) dst[m][k] = *(const LAS bf16x8*)(lds + PG8_SA(b, h) + aoff + m * 2048 + k * 1024); } while (0)
#define PG8_LDB(dst, b, h) do { _Pragma("unroll") for (int n = 0; n < 2; ++n) _Pragma("unroll") for (int k = 0; k < 2; ++k) dst[n][k] = *(const LAS bf16x8*)(lds + PG8_SB(b, h) + boff + n * 2048 + k * 1024); } while (0)
#define PG8_MMA(ai, bj, At, Bt) do { __builtin_amdgcn_s_setprio(1); _Pragma("unroll") for (int m = 0; m < 4; ++m) _Pragma("unroll") for (int n = 0; n < 2; ++n) _Pragma("unroll") for (int k = 0; k < 2; ++k) \
        acc[ai][bj][m][n] = __builtin_amdgcn_mfma_f32_16x16x32_bf16(Bt[n][k], At[m][k], acc[ai][bj][m][n], 0, 0, 0); __builtin_amdgcn_s_setprio(0); } while (0)
#define PG8_WAIT_V(n) asm volatile("s_waitcnt vmcnt(" #n ")" ::: "memory")
#define PG8_WAIT_L(n) asm volatile("s_waitcnt lgkmcnt(" #n ")" ::: "memory")
#define PG8_BAR __builtin_amdgcn_s_barrier()
#define PG8_SCHED __builtin_amdgcn_sched_barrier(0)
    Unit cur, nxt; int ui = 0;
    if (!S.next(0, cur)) return;
    f32x4 acc[2][2][4][2];
#pragma unroll
    for (int a = 0; a < 2; ++a)
#pragma unroll
        for (int b = 0; b < 2; ++b)
#pragma unroll
            for (int m = 0; m < 4; ++m)
#pragma unroll
                for (int n = 0; n < 2; ++n) acc[a][b][m][n] = (f32x4){0.f, 0.f, 0.f, 0.f};
    bf16x8 At[4][2], B0[2][2], B1[2][2];
    const char* cA = (const char*)g.A + (size_t)cur.pm * tsA; const char* cB = (const char*)g.Bt + (size_t)cur.pn * tsB;
    PG8_STAGE(PG8_SB(0, 0), cB, voffB); PG8_STAGE(PG8_SB(0, 1), cB + hsB, voffB); PG8_STAGE(PG8_SA(0, 0), cA, voffA); PG8_STAGE(PG8_SA(0, 1), cA + hsA, voffA);
    if (wr == 1) PG8_BAR;
    PG8_WAIT_V(2); PG8_BAR;
    PG8_STAGE(PG8_SB(1, 0), cB + kstep, voffB); PG8_STAGE(PG8_SA(1, 0), cA + kstep, voffA); PG8_STAGE(PG8_SB(1, 1), cB + hsB + kstep, voffB);
    PG8_WAIT_V(6); PG8_BAR;
    for (;;) {
        const bool has_next = S.next(ui + 1, nxt);
        const char* nA = has_next ? (const char*)g.A + (size_t)nxt.pm * tsA : cA; const char* nB = has_next ? (const char*)g.Bt + (size_t)nxt.pn * tsB : cB;
#pragma unroll 1
        for (int t = 0; t < nt; t += 2) {
            const bool last = (t == nt - 2);
            const char* a1 = cA + (size_t)(t + 1) * kstep;
            const char* a2 = last ? nA : cA + (size_t)(t + 2) * kstep; const char* b2 = last ? nB : cB + (size_t)(t + 2) * kstep;
            const char* a3 = a2 + kstep; const char* b3 = b2 + kstep;
            PG8_LDB(B0, 0, 0); PG8_LDB(B1, 0, 1); PG8_SCHED; PG8_LDA(At, 0, 0); PG8_STAGE(PG8_SA(1, 1), a1 + hsA, voffA);
            PG8_WAIT_V(8); PG8_WAIT_L(0); PG8_BAR; PG8_MMA(0, 0, At, B0); PG8_MMA(0, 1, At, B1); PG8_BAR; PG8_SCHED;
            PG8_LDA(At, 0, 1); PG8_STAGE(PG8_SB(0, 0), b2, voffB); PG8_STAGE(PG8_SB(0, 1), b2 + hsB, voffB); PG8_STAGE(PG8_SA(0, 0), a2, voffA);
            PG8_WAIT_V(8); PG8_WAIT_L(0); PG8_BAR; PG8_MMA(1, 0, At, B0); PG8_MMA(1, 1, At, B1); PG8_BAR; PG8_SCHED;
            PG8_LDB(B0, 1, 0); PG8_LDB(B1, 1, 1); PG8_SCHED; PG8_LDA(At, 1, 0); PG8_STAGE(PG8_SA(0, 1), a2 + hsA, voffA);
            PG8_WAIT_V(8); PG8_WAIT_L(0); PG8_BAR; PG8_MMA(0, 0, At, B0); PG8_MMA(0, 1, At, B1); PG8_BAR; PG8_SCHED;
            PG8_LDA(At, 1, 1); PG8_STAGE(PG8_SB(1, 0), b3, voffB); PG8_STAGE(PG8_SB(1, 1), b3 + hsB, voffB); PG8_STAGE(PG8_SA(1, 0), a3, voffA);
            PG8_WAIT_V(8); PG8_WAIT_L(0); PG8_BAR; PG8_MMA(1, 0, At, B0); PG8_MMA(1, 1, At, B1); PG8_BAR; PG8_SCHED;
        }
        if (wr == 0) PG8_BAR;
        E(acc, cur, wid);
        if (!has_next) break;
#pragma unroll
        for (int a = 0; a < 2; ++a)
#pragma unroll
            for (int b = 0; b < 2; ++b)
#pragma unroll
                for (int m = 0; m < 4; ++m)
#pragma unroll
                    for (int n = 0; n < 2; ++n) acc[a][b][m][n] = (f32x4){0.f, 0.f, 0.f, 0.f};
        cur = nxt; cA = nA; cB = nB; ++ui;
        if (wr == 1) PG8_BAR;
    }
    PG8_WAIT_V(0);
    PG8_BAR;
#undef PG8_SA
#undef PG8_SB
#undef PG8_STAGE
#undef PG8_LDA
#undef PG8_LDB
#undef PG8_MMA
#undef PG8_WAIT_V
#undef PG8_WAIT_L
#undef PG8_BAR
#undef PG8_SCHED
}
}

typedef f32x4 Acc[2][2][4][2];
__device__ __forceinline__ float rstd_of(const float* ssq, int row, float inv_n) { return __builtin_amdgcn_rsqf(ssq[row] * inv_n + EPS); }
__device__ __forceinline__ u32x4 pack8(f32x4 a, f32x4 b) { u32x4 w; w.x = pk2(a[0], a[1]); w.y = pk2(a[2], a[3]); w.z = pk2(b[0], b[1]); w.w = pk2(b[2], b[3]); return w; }

template <int ACT  , bool SSQP>
struct EpiScale {
    static constexpr bool PERM = true;
    bf16_t* O; int ldc; const float* ssq; float inv_n; float* ssqA; float* ssqB;
    __device__ __forceinline__ void operator()(const Acc& acc, const pg8::Unit& u, int wid) const {
        const int lane_ = lane_id_asm(), wr = wid >> 2, wc = wid & 3, fr = lane_ & 15, fq = lane_ >> 4;
        const int row0 = u.pm * 256 + wr * 64 + fr, col0 = u.pn * 256 + wc * 32 + 8 * fq;
        float scv[8];
#pragma unroll
        for (int i = 0; i < 8; ++i) scv[i] = ssq ? ssq[row0 + (i >> 2) * 128 + (i & 3) * 16] : 0.f;
#pragma unroll
        for (int ai = 0; ai < 2; ++ai)
#pragma unroll
            for (int m = 0; m < 4; ++m) {
                const int row = row0 + ai * 128 + m * 16;
                const float sc = ssq ? __builtin_amdgcn_rsqf(scv[ai * 4 + m] * inv_n + EPS) : 1.f;
#pragma unroll
                for (int bj = 0; bj < 2; ++bj) {
                    f32x4 v0 = acc[ai][bj][m][0] * sc, v1 = acc[ai][bj][m][1] * sc;
                    if (ACT == 1) {
#pragma unroll
                        for (int e = 0; e < 4; ++e) { float a = fmaxf(v0[e], 0.f), b = fmaxf(v1[e], 0.f); v0[e] = a * a; v1[e] = b * b; }
                    }
                    *(u32x4*)(O + (size_t)row * ldc + col0 + bj * 128) = pack8(v0, v1);
                    if (SSQP) {
                        float s = 0.f;
#pragma unroll
                        for (int e = 0; e < 4; ++e) s += v0[e] * v0[e] + v1[e] * v1[e];
                        s += __shfl_xor(s, 16); s += __shfl_xor(s, 32);
                        const int hidx = 2 * u.pn + bj;
                        if (fq == 0 && hidx < 5) atomicAdd((hidx < 3 ? ssqA : ssqB) + row, s);
                    }
                }
            }
    }
};

struct EpiRope {
    static constexpr bool PERM = true;
    bf16_t* QK; bf16_t* V; const float* ssq; const float* cosT; const float* sinT;
    __device__ __forceinline__ void operator()(const Acc& acc, const pg8::Unit& u, int wid) const {
        const int lane_ = lane_id_asm(), wr = wid >> 2, wc = wid & 3, fr = lane_ & 15, fq = lane_ >> 4;
        const int row0 = u.pm * 256 + wr * 64 + fr, colL = wc * 32 + 8 * fq, pn = u.pn;
        float scv[8];
#pragma unroll
        for (int i = 0; i < 8; ++i) scv[i] = ssq[row0 + (i >> 2) * 128 + (i & 3) * 16];
        if (pn < 8) {
            const float kmul = pn >= 4 ? 0.0625f : 1.f;
#pragma unroll
            for (int ai = 0; ai < 2; ++ai)
#pragma unroll
                for (int mp = 0; mp < 2; ++mp) {
                    f32x4 c4[2][2], s4[2][2];
#pragma unroll
                    for (int mm = 0; mm < 2; ++mm) { const int s = (row0 + ai * 128 + (2 * mp + mm) * 16) & (SEQ - 1);
#pragma unroll
                        for (int n = 0; n < 2; ++n) { c4[mm][n] = *(const f32x4*)(cosT + (size_t)s * 128 + colL + 4 * n); s4[mm][n] = *(const f32x4*)(sinT + (size_t)s * 128 + colL + 4 * n); } }
#pragma unroll
                    for (int mm = 0; mm < 2; ++mm) { const int m = 2 * mp + mm, row = row0 + ai * 128 + m * 16;
                        const float ks = __builtin_amdgcn_rsqf(scv[ai * 4 + m] * (1.f / 1024.f) + EPS) * kmul;
                        f32x4 o1[2], o2[2];
#pragma unroll
                        for (int n = 0; n < 2; ++n) { const f32x4 x1 = acc[ai][0][m][n] * ks, x2 = acc[ai][1][m][n] * ks;
                            o1[n] = x1 * c4[mm][n] - x2 * s4[mm][n]; o2[n] = x2 * c4[mm][n] + x1 * s4[mm][n]; }
                        bf16_t* p = QK + (size_t)row * 2048 + pn * 256 + colL;
                        *(u32x4*)p = pack8(o1[0], o1[1]); *(u32x4*)(p + 128) = pack8(o2[0], o2[1]); }
                }
        } else {
            const float lgh = __builtin_amdgcn_logf(1.f - __builtin_amdgcn_exp2f(-5.f - (float)((pn - 8) >> 1)));
#pragma unroll
            for (int ai = 0; ai < 2; ++ai)
#pragma unroll
                for (int m = 0; m < 4; ++m) { const int row = row0 + ai * 128 + m * 16;
                    const float sc = __builtin_amdgcn_rsqf(scv[ai * 4 + m] * (1.f / 1024.f) + EPS) * __builtin_amdgcn_exp2f(lgh * (float)(63 - (row & 63)));
                    bf16_t* p = V + (size_t)row * 2048 + (pn - 8) * 256 + colL;
#pragma unroll
                    for (int bj = 0; bj < 2; ++bj) *(u32x4*)(p + bj * 128) = pack8(acc[ai][bj][m][0] * sc, acc[ai][bj][m][1] * sc); }
        }
    }
};

struct EpiGateY {
    static constexpr bool PERM = true;
    bf16_t* Y; const float* ssq; const float* rssq; const float* gn;
    __device__ __forceinline__ void operator()(const Acc& acc, const pg8::Unit& u, int wid) const {
        const int lane_ = lane_id_asm(), wr = wid >> 2, wc = wid & 3, fr = lane_ & 15, fq = lane_ >> 4;
        const int row0 = u.pm * 256 + wr * 64 + fr, col0 = u.pn * 256 + wc * 32 + 8 * fq, head = u.pn >> 1;
        f32x4 g4[2][2];
#pragma unroll
        for (int bj = 0; bj < 2; ++bj) { g4[bj][0] = *(const f32x4*)(gn + col0 + bj * 128); g4[bj][1] = *(const f32x4*)(gn + col0 + bj * 128 + 4); }
#pragma unroll
        for (int ai = 0; ai < 2; ++ai)
#pragma unroll
            for (int mp = 0; mp < 2; ++mp) {
                float scv[2]; f32x4 rq[2][4]; u32x4 ov[2][2];
#pragma unroll
                for (int mm = 0; mm < 2; ++mm) { const int row = row0 + ai * 128 + (2 * mp + mm) * 16;
                    scv[mm] = ssq[row];
                    const f32x4* rp = (const f32x4*)(rssq + (size_t)row * 64 + head * 16);
#pragma unroll
                    for (int i = 0; i < 4; ++i) rq[mm][i] = rp[i];
#pragma unroll
                    for (int bj = 0; bj < 2; ++bj) ov[mm][bj] = *(const u32x4*)(Y + (size_t)row * 2048 + col0 + bj * 128); }
#pragma unroll
                for (int mm = 0; mm < 2; ++mm) { const int m = 2 * mp + mm, row = row0 + ai * 128 + m * 16;
                    const float sc = __builtin_amdgcn_rsqf(scv[mm] * (1.f / 1024.f) + EPS);
                    const f32x4 pa = (rq[mm][0] + rq[mm][1]) + (rq[mm][2] + rq[mm][3]);
                    const float rg = __builtin_amdgcn_rsqf(((pa[0] + pa[1]) + (pa[2] + pa[3])) * (1.f / 512.f) + EPS);
#pragma unroll
                    for (int bj = 0; bj < 2; ++bj) {
                        const u32x4 w = ov[mm][bj];
                        f32x4 o0 = (f32x4){bflo(w.x), bfhi(w.x), bflo(w.y), bfhi(w.y)}, o1 = (f32x4){bflo(w.z), bfhi(w.z), bflo(w.w), bfhi(w.w)};
                        f32x4 a0 = acc[ai][bj][m][0] * sc, a1 = acc[ai][bj][m][1] * sc;
#pragma unroll
                        for (int e = 0; e < 4; ++e) { a0[e] = a0[e] * __builtin_amdgcn_rcpf(1.f + __builtin_amdgcn_exp2f(-1.4426950408889634f * a0[e])); a1[e] = a1[e] * __builtin_amdgcn_rcpf(1.f + __builtin_amdgcn_exp2f(-1.4426950408889634f * a1[e])); }
                        o0 = a0 * o0 * g4[bj][0] * rg; o1 = a1 * o1 * g4[bj][1] * rg;
                        *(u32x4*)(Y + (size_t)row * 2048 + col0 + bj * 128) = pack8(o0, o1);
                    } }
            }
    }
};

struct EpiResidual {
    static constexpr bool PERM = true;
    const bf16_t* base; bf16_t* hb; float* ssq_out; const float* ssq2;
    __device__ __forceinline__ void operator()(const Acc& acc, const pg8::Unit& u, int wid) const {
        const int lane_ = lane_id_asm(), wr = wid >> 2, wc = wid & 3, fr = lane_ & 15, fq = lane_ >> 4;
        const int row0 = u.pm * 256 + wr * 64 + fr, col0 = u.pn * 256 + wc * 32 + 8 * fq;
        float r2[8];
#pragma unroll
        for (int i = 0; i < 8; ++i) r2[i] = ssq2 ? ssq2[row0 + (i >> 2) * 128 + (i & 3) * 16] : 0.f;
        u32x4 bv[2][4][2];
#pragma unroll
        for (int ai = 0; ai < 2; ++ai)
#pragma unroll
            for (int m = 0; m < 4; ++m)
#pragma unroll
                for (int bj = 0; bj < 2; ++bj) bv[ai][m][bj] = *(const u32x4*)(base + (size_t)(row0 + ai * 128 + m * 16) * 1024 + col0 + bj * 128);
#pragma unroll
        for (int ai = 0; ai < 2; ++ai) {
#pragma unroll
            for (int m = 0; m < 4; ++m) {
                const int row = row0 + ai * 128 + m * 16; float sq = 0.f;
                const float rr = ssq2 ? __builtin_amdgcn_rcpf(r2[ai * 4 + m] * (1.f / 1024.f) + EPS) : 1.f;
#pragma unroll
                for (int bj = 0; bj < 2; ++bj) {
                    const u32x4 b4 = bv[ai][m][bj];
                    const f32x4 o0 = (f32x4){bflo(b4.x), bfhi(b4.x), bflo(b4.y), bfhi(b4.y)} + acc[ai][bj][m][0] * rr;
                    const f32x4 o1 = (f32x4){bflo(b4.z), bfhi(b4.z), bflo(b4.w), bfhi(b4.w)} + acc[ai][bj][m][1] * rr;
                    *(u32x4*)(hb + (size_t)row * 1024 + col0 + bj * 128) = pack8(o0, o1);
                    sq += (o0[0] * o0[0] + o0[1] * o0[1]) + (o0[2] * o0[2] + o0[3] * o0[3]) + (o1[0] * o1[0] + o1[1] * o1[1]) + (o1[2] * o1[2] + o1[3] * o1[3]);
                }
                if (ssq_out) { sq += __shfl_xor(sq, 16); sq += __shfl_xor(sq, 32); if (fq == 0) atomicAdd(ssq_out + row, sq); }
            }
        }
    }
};

struct EpiPlainNP {
    static constexpr bool PERM = true;
    bf16_t* O;
    __device__ __forceinline__ void operator()(const Acc& acc, const pg8::Unit& u, int wid) const {
        const int lane_ = lane_id_asm(), wr = wid >> 2, wc = wid & 3, fr = lane_ & 15, fq = lane_ >> 4;
        const int row0 = u.pm * 256 + wr * 64 + fr, col0 = u.pn * 256 + wc * 32 + 8 * fq;
#pragma unroll
        for (int ai = 0; ai < 2; ++ai)
#pragma unroll
            for (int m = 0; m < 4; ++m)
#pragma unroll
                for (int bj = 0; bj < 2; ++bj) *(u32x4*)(O + (size_t)(row0 + ai * 128 + m * 16) * 1024 + col0 + bj * 128) = pack8(acc[ai][bj][m][0], acc[ai][bj][m][1]);
    }
};

struct EpiPle {
    static constexpr bool PERM = true;
    const bf16_t* hbase; const bf16_t* pp; const float* ssq; bf16_t* hb_out; float* ssq_out; float* fout;
    __device__ __forceinline__ void operator()(const Acc& acc, const pg8::Unit& u, int wid) const {
        const int lane_ = lane_id_asm(), wr = wid >> 2, wc = wid & 3, fr = lane_ & 15, fq = lane_ >> 4;
        const int row0 = u.pm * 256 + wr * 64 + fr, col0 = u.pn * 256 + wc * 32 + 8 * fq;
#pragma unroll
        for (int ai = 0; ai < 2; ++ai)
#pragma unroll
            for (int mp = 0; mp < 2; ++mp) {
                u32x4 hv[2][2], pw[2][2]; float scv[2];
#pragma unroll
                for (int mm = 0; mm < 2; ++mm) {
                    const int row = row0 + ai * 128 + (2 * mp + mm) * 16;
                    scv[mm] = ssq[row];
#pragma unroll
                    for (int bj = 0; bj < 2; ++bj) { const size_t off = (size_t)row * 1024 + col0 + bj * 128; hv[mm][bj] = *(const u32x4*)(hbase + off); pw[mm][bj] = *(const u32x4*)(pp + off); }
                }
#pragma unroll
                for (int mm = 0; mm < 2; ++mm) {
                    const int m = 2 * mp + mm, row = row0 + ai * 128 + m * 16; float sq = 0.f;
                    const float sc = __builtin_amdgcn_rsqf(scv[mm] * (1.f / 1024.f) + EPS);
#pragma unroll
                    for (int bj = 0; bj < 2; ++bj) {
                        const size_t off = (size_t)row * 1024 + col0 + bj * 128;
                        const u32x4 pwv = pw[mm][bj], hw = hv[mm][bj];
                        const f32x4 p0 = (f32x4){bflo(pwv.x), bfhi(pwv.x), bflo(pwv.y), bfhi(pwv.y)}, p1 = (f32x4){bflo(pwv.z), bfhi(pwv.z), bflo(pwv.w), bfhi(pwv.w)};
                        f32x4 g0 = acc[ai][bj][m][0] * sc, g1 = acc[ai][bj][m][1] * sc;
#pragma unroll
                        for (int e = 0; e < 4; ++e) { g0[e] = __builtin_amdgcn_rcpf(1.f + __builtin_amdgcn_exp2f(-1.4426950408889634f * g0[e])); g1[e] = __builtin_amdgcn_rcpf(1.f + __builtin_amdgcn_exp2f(-1.4426950408889634f * g1[e])); }
                        const f32x4 o0 = (f32x4){bflo(hw.x), bfhi(hw.x), bflo(hw.y), bfhi(hw.y)} + g0 * p0;
                        const f32x4 o1 = (f32x4){bflo(hw.z), bfhi(hw.z), bflo(hw.w), bfhi(hw.w)} + g1 * p1;
                        if (fout) { *(f32x4*)(fout + off) = o0; *(f32x4*)(fout + off + 4) = o1; }
                        if (hb_out) *(u32x4*)(hb_out + off) = pack8(o0, o1);
                        sq += (o0[0] * o0[0] + o0[1] * o0[1]) + (o0[2] * o0[2] + o0[3] * o0[3]) + (o1[0] * o1[0] + o1[1] * o1[1]) + (o1[2] * o1[2] + o1[3] * o1[3]);
                    }
                    if (ssq_out) { sq += __shfl_xor(sq, 16); sq += __shfl_xor(sq, 32); if (fq == 0) atomicAdd(ssq_out + row, sq); }
                }
            }
    }
};

__device__ __forceinline__ void transpose_item(const float* W, int K, int N, bf16_t* WT, const float* gain, int mapmode, LAS float* scr, int item, int lane) {
    const int nblk = N / 64, kb = item / nblk, nb = item % nblk, k0 = 64 * kb, n0 = 64 * nb;
    const int lr = lane >> 4, lc = lane & 15;
    f32x4 v[16];
#pragma unroll
    for (int i = 0; i < 16; ++i) v[i] = __builtin_nontemporal_load((const f32x4*)(W + (size_t)(k0 + 4 * i + lr) * N + n0 + 4 * lc));
#pragma unroll
    for (int i = 0; i < 16; ++i) { const float gk = gain ? gain[k0 + 4 * i + lr] : 1.f; *(LAS f32x4*)(scr + (4 * i + lr) * 68 + 4 * lc) = v[i] * gk; }
    asm volatile("s_waitcnt lgkmcnt(0)" ::: "memory");
    const int c = lane & 7;
#pragma unroll
    for (int j = 0; j < 8; ++j) { const int n = (lane >> 3) + 8 * j; const LAS float* s = scr + (8 * c) * 68 + n;
        u32x4 o; o.x = pk2(s[0 * 68], s[1 * 68]); o.y = pk2(s[2 * 68], s[3 * 68]); o.z = pk2(s[4 * 68], s[5 * 68]); o.w = pk2(s[6 * 68], s[7 * 68]);
        int nn = n0 + n; if (mapmode == 1) { const int hh = nn >> 8, jj = nn & 255; nn = hh * 320 + (jj < 128 ? jj : jj + 64); }
        *(u32x4*)(WT + (size_t)nn * K + k0 + 8 * c) = o; }
    asm volatile("s_waitcnt lgkmcnt(0)" ::: "memory");
}

__device__ __forceinline__ void prologue(const Params& P, LAS unsigned char* lds, int wave) {
    const int lane = lane_id_asm();
    unsigned char* ws = P.ws;
    bf16_t* Wb = (bf16_t*)(ws + WS_W);
    LAS float* scr = (LAS float*)(lds + wave * 17408);
    const int G = gridDim.x, gw = blockIdx.x * NWAVES + wave, NGW = G * NWAVES;
    const int gt = blockIdx.x * NTHREADS + wave * 64 + lane, NGT = G * NTHREADS;
    constexpr int IT0 = 16 * 96, IT1 = 32 * 16, IT2 = 16 * 11, IT3 = 6 * 24, IT4 = 4 * 32, IT5 = 16 * 16, IT6 = 16 * 64, IT8 = 64 * 16, IT10 = 16 * 16, IT12 = 4 * 16;
    constexpr int NIT = IT0 + IT1 + IT2 + IT3 + IT4 + IT5 + 2 * IT6 + 2 * IT8 + 2 * IT10 + 2 * IT12;
#pragma unroll 1
    for (int it0 = gw; it0 < NIT; it0 += NGW) {
        const int it = NIT - 1 - it0;   int r = it; const float* W; int K, N, mapmode = 0; bf16_t* WT; const float* gain = nullptr;
        if (r < IT0) { W = P.in[3]; K = 1024; N = 6144; WT = Wb + W_RIN; gain = P.in[2]; }
        else if ((r -= IT0) < IT1) { W = P.in[5]; K = 2048; N = 1024; WT = Wb + W_ROUT; }
        else if ((r -= IT1) < IT2) { W = P.in[6]; K = 1024; N = 704; WT = Wb + W_MIN; gain = P.in[2] + 1024; }
        else if ((r -= IT2) < IT3) { W = P.in[9]; K = 384; N = 1536; WT = Wb + W_UQ; gain = P.in[7]; }
        else if ((r -= IT3) < IT4) { W = P.in[10]; K = 256; N = 2048; WT = Wb + W_UKV; gain = P.in[8]; mapmode = 1; }
        else if ((r -= IT4) < IT5) { W = P.in[13]; K = 1024; N = 1024; WT = Wb + W_MOUT; }
        else if ((r -= IT5) < 2 * IT6) { const int l = r >= IT6; r -= l * IT6; W = P.in[15] + (size_t)l * 1024 * 4096; K = 1024; N = 4096; WT = Wb + W_1 + (size_t)l * 4194304; gain = P.in[14] + l * 1024; }
        else if ((r -= 2 * IT6) < 2 * IT8) { const int l = r >= IT8; r -= l * IT8; W = P.in[16] + (size_t)l * 4096 * 1024; K = 4096; N = 1024; WT = Wb + W_2 + (size_t)l * 4194304; }
        else if ((r -= 2 * IT8) < 2 * IT10) { const int l = r >= IT10; r -= l * IT10; W = P.in[18] + (size_t)l * 1024 * 1024; K = 1024; N = 1024; WT = Wb + W_G + (size_t)l * 1048576; gain = P.in[17] + l * 1024; }
        else { r -= 2 * IT10; const int l = r >= IT12; r -= l * IT12; W = P.in[19] + (size_t)l * 256 * 1024; K = 256; N = 1024; WT = Wb + W_P + (size_t)l * 262144; }
        transpose_item(W, K, N, WT, gain, mapmode, scr, r, lane);
    }
    for (int i = gt; i < 64 * 1024 / 8; i += NGT) *(u32x4*)(Wb + W_MIN + (size_t)704 * 1024 + (size_t)i * 8) = (u32x4){0u, 0u, 0u, 0u};
    for (int i = gt; i < 8 * 64 * 256 / 8; i += NGT) { const int e = i * 8, hh = e / (64 * 256), r = (e / 256) % 64, c = e % 256;
        *(u32x4*)(Wb + W_UKV + (size_t)(hh * 320 + 128 + r) * 256 + c) = (u32x4){0u, 0u, 0u, 0u}; }
    { float* sq = (float*)(ws + WS_SSQ) + MT; for (int i = gt; i < 7 * MT / 4; i += NGT) *(f32x4*)(sq + (size_t)i * 4) = (f32x4){0.f, 0.f, 0.f, 0.f}; }
    { float* cR = (float*)(ws + WS_ROPE_R); float* sR = cR + 4096 * 128;
      for (int i = gt; i < 4096 * 128; i += NGT) { const int s = i >> 7, j = i & 127;
          const float inv = (float)exp2(-(double)j * (13.287712379549449 / 128.0)); const float ang = (float)s * inv;
          const double rev = (double)ang * 0.15915494309189535; const float fr = (float)(rev - rint(rev));
          cR[i] = __builtin_amdgcn_cosf(fr); sR[i] = __builtin_amdgcn_sinf(fr); }
      float* cM = (float*)(ws + WS_ROPE_M); float* sM = cM + 4096 * 32;
      for (int i = gt; i < 4096 * 32; i += NGT) { const int s = i >> 5, j = i & 31;
          const float inv = (float)exp2(-(double)j * (13.287712379549449 / 32.0)); const float ang = (float)s * inv;
          const double rev = (double)ang * 0.15915494309189535; const float fr = (float)(rev - rint(rev));
          cM[i] = __builtin_amdgcn_cosf(fr); sM[i] = __builtin_amdgcn_sinf(fr); } }
    { float* sm = (float*)(ws + WS_SMALL); for (int i = gt; i < 2048 + 384; i += NGT) sm[i] = i < 2048 ? P.in[4][i] : (i < 2240 ? P.in[11][i - 2048] : P.in[12][i - 2240]); }
    { const f32x4* p4 = (const f32x4*)P.in[1]; u32x2* pb = (u32x2*)(ws + WS_PB);
#pragma unroll 1
      for (int i = gt; i < 2 * MT * 256 / 4; i += 4 * NGT) {
          f32x4 v[4];
#pragma unroll
          for (int j = 0; j < 4; ++j) v[j] = (i + j * NGT < 2 * MT * 256 / 4) ? __builtin_nontemporal_load(p4 + i + j * NGT) : (f32x4){0.f, 0.f, 0.f, 0.f};
#pragma unroll
          for (int j = 0; j < 4; ++j) if (i + j * NGT < 2 * MT * 256 / 4) { u32x2 w; w.x = pk2(v[j][0], v[j][1]); w.y = pk2(v[j][2], v[j][3]); pb[i + j * NGT] = w; }
      } }
    { const float* x = P.in[0]; bf16_t* hb = (bf16_t*)(ws + WS_HBA); float* sq = (float*)(ws + WS_SSQ);
#pragma unroll 1
      for (int r = 2 * gw; r < MT; r += 2 * NGW) {
          const f32x4* xr = (const f32x4*)(x + (size_t)r * 1024) + lane; f32x4 v[8]; float s0 = 0.f, s1 = 0.f;
#pragma unroll
          for (int j = 0; j < 8; ++j) v[j] = __builtin_nontemporal_load(xr + 64 * j);
#pragma unroll
          for (int j = 0; j < 4; ++j) { s0 += (v[j][0] * v[j][0] + v[j][1] * v[j][1]) + (v[j][2] * v[j][2] + v[j][3] * v[j][3]);
              s1 += (v[4 + j][0] * v[4 + j][0] + v[4 + j][1] * v[4 + j][1]) + (v[4 + j][2] * v[4 + j][2] + v[4 + j][3] * v[4 + j][3]); }
          s0 = wave_sum(s0); s1 = wave_sum(s1); if (lane == 0) { sq[r] = s0; sq[r + 1] = s1; }
          u32x2* o = (u32x2*)(hb + (size_t)r * 1024) + lane;
#pragma unroll
          for (int j = 0; j < 8; ++j) { u32x2 w; w.x = pk2(v[j][0], v[j][1]); w.y = pk2(v[j][2], v[j][3]); o[64 * j] = w; }
      } }
}

struct FinRow { u32x4 kn0, kn1; u32x2 kr0, kr1; f32x4 c4, s4; };
__device__ __forceinline__ void fin_load(FinRow& R, const bf16_t* Q, const bf16_t* KV, const bf16_t* CQ, const float* cM, const float* sM, int r, int hh, int tt) {
    const bf16_t* kp = KV + (size_t)r * 2560 + hh * 320; const bf16_t* kr = CQ + (size_t)r * 768 + 640;
    const int s = r & (SEQ - 1);
    R.kn0 = *(const u32x4*)(kp + 16 * tt); R.kn1 = *(const u32x4*)(kp + 16 * tt + 8); R.kr0 = *(const u32x2*)(kr + 4 * tt); R.kr1 = *(const u32x2*)(kr + 32 + 4 * tt);
    R.c4 = *(const f32x4*)(cM + s * 32 + 4 * tt); R.s4 = *(const f32x4*)(sM + s * 32 + 4 * tt);
}
__device__ __forceinline__ void fin_one(bf16_t* dst, const u32x4 n0, const u32x4 n1, const u32x2 r0, const u32x2 r1, const f32x4 c4, const f32x4 s4, const float* gain, int tt, float scale) {
    float nv[16] = {bflo(n0.x), bfhi(n0.x), bflo(n0.y), bfhi(n0.y), bflo(n0.z), bfhi(n0.z), bflo(n0.w), bfhi(n0.w),
                    bflo(n1.x), bfhi(n1.x), bflo(n1.y), bfhi(n1.y), bflo(n1.z), bfhi(n1.z), bflo(n1.w), bfhi(n1.w)};
    float x1[4] = {bflo(r0.x), bfhi(r0.x), bflo(r0.y), bfhi(r0.y)}, x2[4] = {bflo(r1.x), bfhi(r1.x), bflo(r1.y), bfhi(r1.y)};
    float sq = 0.f;
#pragma unroll
    for (int j = 0; j < 16; ++j) sq += nv[j] * nv[j];
#pragma unroll
    for (int j = 0; j < 4; ++j) sq += x1[j] * x1[j] + x2[j] * x2[j];
    sq += __shfl_xor(sq, 1); sq += __shfl_xor(sq, 2); sq += __shfl_xor(sq, 4);
    const float rs = __builtin_amdgcn_rsqf(sq * (1.f / 192.f) + EPS) * scale;
#pragma unroll
    for (int j = 0; j < 16; ++j) nv[j] *= rs * gain[16 * tt + j];
    float o1[4], o2[4];
#pragma unroll
    for (int j = 0; j < 4; ++j) { const float a = x1[j] * rs * gain[128 + 4 * tt + j], bq = x2[j] * rs * gain[160 + 4 * tt + j]; o1[j] = a * c4[j] - bq * s4[j]; o2[j] = bq * c4[j] + a * s4[j]; }
    u32x4 w0, w1; w0.x = pk2(nv[0], nv[1]); w0.y = pk2(nv[2], nv[3]); w0.z = pk2(nv[4], nv[5]); w0.w = pk2(nv[6], nv[7]);
    w1.x = pk2(nv[8], nv[9]); w1.y = pk2(nv[10], nv[11]); w1.z = pk2(nv[12], nv[13]); w1.w = pk2(nv[14], nv[15]);
    *(u32x4*)(dst + 16 * tt) = w0; *(u32x4*)(dst + 16 * tt + 8) = w1;
    u32x2 v0, v1; v0.x = pk2(o1[0], o1[1]); v0.y = pk2(o1[2], o1[3]); v1.x = pk2(o2[0], o2[1]); v1.y = pk2(o2[2], o2[3]);
    *(u32x2*)(dst + 128 + 4 * tt) = v0; *(u32x2*)(dst + 160 + 4 * tt) = v1;
}
__device__ __forceinline__ void mla_finalize(const Params& P, int wave) {
    const int lane = lane_id_asm();
    unsigned char* ws = P.ws;
    bf16_t* Q = (bf16_t*)(ws + WS_R + R_Q); bf16_t* KV = (bf16_t*)(ws + WS_R + R_KV); const bf16_t* CQ = (const bf16_t*)(ws + WS_R + R_CQKV);
    const float* cM = (const float*)(ws + WS_ROPE_M); const float* sM = cM + 4096 * 32;
    const float* qg = (const float*)(ws + WS_SMALL) + 2048; const float* kg = qg + 192;
    const int hh = lane >> 3, tt = lane & 7;
    const float qscale = 0.07216878364870322f * 1.4426950408889634f;
    const int gw = blockIdx.x * NWAVES + wave, NGW = gridDim.x * NWAVES;
#pragma unroll 1
    for (int r = gw; r < MT; r += 2 * NGW) {
        const int r2 = r + NGW; const bool two = r2 < MT;
        FinRow A, B;
        fin_load(A, Q, KV, CQ, cM, sM, r, hh, tt);
        fin_load(B, Q, KV, CQ, cM, sM, two ? r2 : r, hh, tt);
        fin_one(KV + (size_t)r * 2560 + hh * 320, A.kn0, A.kn1, A.kr0, A.kr1, A.c4, A.s4, kg, tt, 1.f);
        if (two) {
            fin_one(KV + (size_t)r2 * 2560 + hh * 320, B.kn0, B.kn1, B.kr0, B.kr1, B.c4, B.s4, kg, tt, 1.f);
        }
    }
}

typedef float f32x16 __attribute__((ext_vector_type(16)));
typedef short v4i16_t __attribute__((ext_vector_type(4)));
__device__ __forceinline__ bf16x8 tr_pair(const LAS unsigned char* p0, const LAS unsigned char* p1) {
    const v4i16_t lo = __builtin_amdgcn_ds_read_tr16_b64_v4i16((LAS v4i16_t*)p0), hi = __builtin_amdgcn_ds_read_tr16_b64_v4i16((LAS v4i16_t*)p1);
    return (bf16x8){lo[0], lo[1], lo[2], lo[3], hi[0], hi[1], hi[2], hi[3]};
}
__device__ __forceinline__ bf16x8 pack8bf(float a0, float a1, float a2, float a3, float a4, float a5, float a6, float a7) {
    u32x4 w; w.x = cvt_pk_bf16(a0, a1); w.y = cvt_pk_bf16(a2, a3); w.z = cvt_pk_bf16(a4, a5); w.w = cvt_pk_bf16(a6, a7); return __builtin_bit_cast(bf16x8, w);
}
typedef short s16x4 __attribute__((ext_vector_type(4)));
#define TR_READ(dst, addr, off) asm volatile("ds_read_b64_tr_b16 %0, %1 offset:%c2" : "=v"(dst) : "v"(addr), "i"(off) : "memory")
#define TR_WAIT4(n, a, b, c, d) asm volatile("s_waitcnt lgkmcnt(" #n ")" : "+v"(a), "+v"(b), "+v"(c), "+v"(d) :: "memory")
__device__ __forceinline__ void att_qk_sm(const LAS unsigned char* kb, int klane, const bf16x8 (&qf)[12], f32x16 (&o)[4], float& mrun, float& lrun, bf16x8 (&pb)[4]) {
    constexpr int KP = 400;
    f32x16 s0, s1;
#pragma unroll
    for (int i = 0; i < 16; ++i) { s0[i] = 0.f; s1[i] = 0.f; }
    bf16x8 ka[3][2];
#pragma unroll
    for (int g = 0; g < 2; ++g) { ka[g][0] = *(const LAS bf16x8*)(kb + klane + g * 32); ka[g][1] = *(const LAS bf16x8*)(kb + klane + 32 * KP + g * 32); }
#pragma unroll
    for (int g = 0; g < 12; ++g) {
        if (g < 10) { ka[(g + 2) % 3][0] = *(const LAS bf16x8*)(kb + klane + (g + 2) * 32); ka[(g + 2) % 3][1] = *(const LAS bf16x8*)(kb + klane + 32 * KP + (g + 2) * 32); }
        __builtin_amdgcn_sched_barrier(0);
        s0 = __builtin_amdgcn_mfma_f32_32x32x16_bf16(ka[g % 3][0], qf[g], s0, 0, 0, 0);
        s1 = __builtin_amdgcn_mfma_f32_32x32x16_bf16(ka[g % 3][1], qf[g], s1, 0, 0, 0);
        __builtin_amdgcn_sched_barrier(0);
    }
    float mx = fmaxf(s0[0], s1[0]);
#pragma unroll
    for (int i = 1; i < 16; ++i) asm("v_max3_f32 %0, %1, %2, %3" : "=v"(mx) : "v"(mx), "v"(s0[i]), "v"(s1[i]));
    { const auto rr = __builtin_amdgcn_permlane32_swap(__float_as_uint(mx), __float_as_uint(mx), false, false);
      mx = fmaxf(__uint_as_float(rr[0]), __uint_as_float(rr[1])); }
    if (!__all(mx - mrun <= 8.0f)) {
        const float mn = fmaxf(mrun, mx), al = __builtin_amdgcn_exp2f(mrun - mn);
        mrun = mn; lrun *= al;
#pragma unroll
        for (int d = 0; d < 4; ++d) o[d] = o[d] * al;
    }
    float ps = 0.f;
#pragma unroll
    for (int i = 0; i < 16; ++i) { s0[i] = __builtin_amdgcn_exp2f(s0[i] - mrun); s1[i] = __builtin_amdgcn_exp2f(s1[i] - mrun); ps += s0[i] + s1[i]; }
    lrun += ps;
    pb[0] = pack8bf(s0[0], s0[1], s0[2], s0[3], s0[4], s0[5], s0[6], s0[7]);
    pb[1] = pack8bf(s0[8], s0[9], s0[10], s0[11], s0[12], s0[13], s0[14], s0[15]);
    pb[2] = pack8bf(s1[0], s1[1], s1[2], s1[3], s1[4], s1[5], s1[6], s1[7]);
    pb[3] = pack8bf(s1[8], s1[9], s1[10], s1[11], s1[12], s1[13], s1[14], s1[15]);
    __builtin_amdgcn_sched_barrier(0);
}
__device__ __forceinline__ void att_pv(const LAS unsigned char* kb, int vlane, const bf16x8 (&pb)[4], f32x16 (&o)[4]) {
    constexpr int VP = 320;
    s16x4 vlo[2][4], vhi[2][4];
    const unsigned vaddr = (unsigned)(unsigned long)(kb + vlane);
#pragma unroll
    for (int d = 0; d < 4; ++d) { TR_READ(vlo[0][d], vaddr, d * 64); TR_READ(vhi[0][d], vaddr, 8 * VP + d * 64); }
#pragma unroll
    for (int ks = 0; ks < 4; ++ks) {
        if (ks < 3) {
#pragma unroll
            for (int d = 0; d < 4; ++d) { TR_READ(vlo[(ks + 1) & 1][d], vaddr, ((ks + 1) * 16) * VP + d * 64); TR_READ(vhi[(ks + 1) & 1][d], vaddr, ((ks + 1) * 16 + 8) * VP + d * 64); }
            TR_WAIT4(8, vlo[ks & 1][0], vlo[ks & 1][1], vlo[ks & 1][2], vlo[ks & 1][3]); TR_WAIT4(8, vhi[ks & 1][0], vhi[ks & 1][1], vhi[ks & 1][2], vhi[ks & 1][3]);
        } else {
            TR_WAIT4(0, vlo[ks & 1][0], vlo[ks & 1][1], vlo[ks & 1][2], vlo[ks & 1][3]); TR_WAIT4(0, vhi[ks & 1][0], vhi[ks & 1][1], vhi[ks & 1][2], vhi[ks & 1][3]);
        }
        __builtin_amdgcn_sched_barrier(0);
#pragma unroll
        for (int d = 0; d < 4; ++d) { const bf16x8 a = __builtin_shufflevector(vlo[ks & 1][d], vhi[ks & 1][d], 0, 1, 2, 3, 4, 5, 6, 7);
            o[d] = __builtin_amdgcn_mfma_f32_32x32x16_bf16(a, pb[ks], o[d], 0, 0, 0); }
        __builtin_amdgcn_sched_barrier(0);
    }
}
__device__ __forceinline__ void att_mfma(const Params& P, LAS unsigned char* lds, int wave) {
    unsigned char* ws = P.ws;
    const bf16_t* Q = (const bf16_t*)(ws + WS_R + R_Q); const bf16_t* KV = (const bf16_t*)(ws + WS_R + R_KV); bf16_t* O = (bf16_t*)(ws + WS_R + R_O);
    const int lane = lane_id_asm(), q32 = lane & 31, hf = lane >> 5;
    constexpr int KP = 400, VP = 320, KB = 64 * KP, BUF = KB + 64 * VP;
    unsigned goff[6];
#pragma unroll
    for (int i = 0; i < 6; ++i) { int q = wave + 8 * i; q = q > 44 ? 44 : q; int p = q * 64 + lane;
        if (q < 25) { const int r = p / 25; int c = p % 25; c = c == 24 ? 0 : c; goff[i] = (unsigned)(r * 5120 + c * 16); }
        else { p -= 1600; const int r = p / 20; int c = p % 20; c = c >= 16 ? 0 : c; goff[i] = (unsigned)(r * 5120 + 384 + c * 16); } }
#define ATT_ISSUE(tilebase, bufbase) do { const unsigned char* _tb = (tilebase); asm volatile("" : "+s"(_tb)); _Pragma("unroll") for (int _i = 0; _i < 6; ++_i) { int _q = wave + 8 * _i; _q = _q > 44 ? 44 : _q; \
        __builtin_amdgcn_global_load_lds((const unsigned*)(_tb + goff[_i]), (LAS unsigned*)((bufbase) + _q * 1024), 16, 0, 0); } } while (0)
#define ATT_BAR() do { asm volatile("s_waitcnt vmcnt(0) lgkmcnt(0)" ::: "memory"); __builtin_amdgcn_s_barrier(); asm volatile("" ::: "memory"); } while (0)
    const int i16 = lane & 15, blk = (lane >> 4) & 1;
    const int vlane = KB + ((i16 >> 2) + 4 * hf) * VP + (16 * blk + 4 * (i16 & 3)) * 2;
    const int klane = q32 * KP + hf * 16;
    const bool roleA = wave < 4;
    const int w4 = wave & 3;
    for (int u = blockIdx.x; u < 1024; u += gridDim.x) {
        const int bh = u & 63, r = u >> 6, kk = r >> 2, j4 = r & 3;
        const int qb = kk == 0 ? j4 : (kk == 1 ? 15 - j4 : (kk == 2 ? 4 + j4 : 11 - j4));
        const int b = bh >> 3, hh = bh & 7;
        const int ntile = 4 * qb + 4, my_last = 4 * qb + w4;
        const size_t qrow_g = (size_t)b * SEQ + qb * 256 + w4 * 64 + (wave >> 2) * 32 + q32;
        const unsigned char* kvb = (const unsigned char*)(KV + (size_t)b * SEQ * 2560 + hh * 320);
        ATT_ISSUE(kvb, lds);
        bf16x8 qf[12];
        { const bf16_t* qp = Q + qrow_g * 1536 + hh * 192 + hf * 8;
#pragma unroll
          for (int ks = 0; ks < 12; ++ks) qf[ks] = *(const bf16x8*)(qp + ks * 16); }
        f32x16 o[4];
#pragma unroll
        for (int d = 0; d < 4; ++d)
#pragma unroll
            for (int i = 0; i < 16; ++i) o[d][i] = 0.f;
        float mrun = -1e30f, lrun = 0.f;
        bf16x8 pb[4];
#pragma unroll
        for (int i = 0; i < 4; ++i) pb[i] = (bf16x8){0, 0, 0, 0, 0, 0, 0, 0};
        ATT_BAR();
#pragma unroll
        for (int ks = 0; ks < 12; ++ks) asm volatile("" : "+v"(qf[ks]));
        {
            float qv[12][8]; float sq = 0.f;
#pragma unroll
            for (int ks = 0; ks < 12; ++ks)
#pragma unroll
                for (int e = 0; e < 8; ++e) { qv[ks][e] = bf2f((unsigned short)qf[ks][e]); sq += qv[ks][e] * qv[ks][e]; }
            { const auto rr = __builtin_amdgcn_permlane32_swap(__float_as_uint(sq), __float_as_uint(sq), false, false);
              sq = __uint_as_float(rr[0]) + __uint_as_float(rr[1]); }
            const float rs = __builtin_amdgcn_rsqf(sq * (1.f / 192.f) + EPS) * (0.07216878364870322f * 1.4426950408889634f);
            const float* qg = (const float*)(ws + WS_SMALL) + 2048 + 8 * hf;
            const int spos = (int)(qrow_g & (SEQ - 1));
            const float* cM = (const float*)(ws + WS_ROPE_M) + spos * 32 + 8 * hf; const float* sM = cM + 4096 * 32;
#pragma unroll
            for (int ks = 0; ks < 12; ++ks) { const f32x4 g0 = *(const f32x4*)(qg + 16 * ks), g1 = *(const f32x4*)(qg + 16 * ks + 4);
#pragma unroll
                for (int e = 0; e < 4; ++e) { qv[ks][e] *= rs * g0[e]; qv[ks][4 + e] *= rs * g1[e]; } }
#pragma unroll
            for (int k2 = 0; k2 < 2; ++k2) {
                const f32x4 c0 = *(const f32x4*)(cM + 16 * k2), c1 = *(const f32x4*)(cM + 16 * k2 + 4), s0 = *(const f32x4*)(sM + 16 * k2), s1 = *(const f32x4*)(sM + 16 * k2 + 4);
#pragma unroll
                for (int e = 0; e < 8; ++e) { const float cc = e < 4 ? c0[e & 3] : c1[e & 3], ss = e < 4 ? s0[e & 3] : s1[e & 3];
                    const float a = qv[8 + k2][e], bq = qv[10 + k2][e]; qv[8 + k2][e] = a * cc - bq * ss; qv[10 + k2][e] = bq * cc + a * ss; }
            }
#pragma unroll
            for (int ks = 0; ks < 12; ++ks) qf[ks] = pack8bf(qv[ks][0], qv[ks][1], qv[ks][2], qv[ks][3], qv[ks][4], qv[ks][5], qv[ks][6], qv[ks][7]);
        }
        int bcur = 0, bprev = 2, bnext = 1;
#pragma unroll 1
        for (int kt = 0; kt < ntile; ++kt) {
            if (kt + 1 < ntile) ATT_ISSUE(kvb + (size_t)(kt + 1) * 327680, lds + bnext * BUF);
            if (!roleA && kt >= 1 && kt - 1 <= my_last) att_pv(lds + bprev * BUF, vlane, pb, o);
            if (kt <= my_last) att_qk_sm(lds + bcur * BUF, klane, qf, o, mrun, lrun, pb);
            if (roleA && kt <= my_last) att_pv(lds + bcur * BUF, vlane, pb, o);
            ATT_BAR();
            bprev = bcur; bcur = bnext; bnext = bnext == 2 ? 0 : bnext + 1;
        }
        if (!roleA && ntile - 1 <= my_last) att_pv(lds + bprev * BUF, vlane, pb, o);
        ATT_BAR();
        const float lt = lrun + __shfl_xor(lrun, 32), il = 1.f / lt;
        bf16_t* op = O + qrow_g * 1024 + hh * 128 + 4 * hf;
#pragma unroll
        for (int d = 0; d < 4; ++d)
#pragma unroll
            for (int j = 0; j < 4; ++j) { u32x2 w; w.x = cvt_pk_bf16(o[d][4 * j] * il, o[d][4 * j + 1] * il); w.y = cvt_pk_bf16(o[d][4 * j + 2] * il, o[d][4 * j + 3] * il);
                *(u32x2*)(op + d * 32 + 8 * j) = w; }
    }
#undef ATT_ISSUE
#undef ATT_BAR
}

__device__ __forceinline__ void ret_mfma(const Params& P, LAS unsigned char* lds, int wave) {
    unsigned char* ws = P.ws;
    const bf16_t* QK = (const bf16_t*)(ws + WS_R + R_QK); bf16_t* V = (bf16_t*)(ws + WS_R + R_V); float* rssq = (float*)(ws + WS_RSSQ);
    constexpr int QP = 528, VP = 192, SP = 144;
    constexpr int Q_OFF = 0, K_OFF = 33792, V_OFF = 67584, VS_OFF = 79872, ST_OFF = 92160, S_OFF = 125952;
    const int lane = lane_id_asm(), t = wave * 64 + lane, q32 = lane & 31, hf = lane >> 5, i16 = lane & 15, blk = (lane >> 4) & 1;
    const int trrow = 8 * hf + (i16 >> 2), trcol = (16 * blk + 4 * (i16 & 3)) * 2;
    for (int unit = blockIdx.x; unit < 256; unit += gridDim.x) {
        const int xcd_ = unit & 7, idx_ = unit >> 3, bh = xcd_ * 4 + (idx_ >> 3), slice = idx_ & 7, b = bh >> 2, hh = bh & 3;
        const float gam = 1.f - exp2f(-5.f - (float)hh), lg = log2f(gam), g64 = exp2f(lg * 64.f);
        for (int i = t; i < 33792 / 16; i += NTHREADS) *(LAS u32x4*)(lds + ST_OFF + i * 16) = (u32x4){0u, 0u, 0u, 0u};
        f32x16 st[2];
#pragma unroll
        for (int a = 0; a < 2; ++a)
#pragma unroll
            for (int i = 0; i < 16; ++i) st[a][i] = 0.f;
        const size_t rb = (size_t)b * SEQ;
        float dec[16];
        { const int mblk = (wave & 3) >> 1, nblk = wave & 1, n = nblk * 32 + q32;
#pragma unroll
          for (int i = 0; i < 16; ++i) { const int mm = mblk * 32 + 8 * (i >> 2) + 4 * hf + (i & 3); const int dist = n > mm ? n - mm : mm - n;
              dec[i] = wave < 4 ? __builtin_amdgcn_exp2f(lg * (float)(dist - (63 - mm))) : __builtin_amdgcn_exp2f(lg * (float)(n + 1)); } }
        u32x4 pq[4], pkk[4], pvv;
        const int vr = t >> 3, vc = t & 7;
#pragma unroll
        for (int i = 0; i < 4; ++i) { const int id = t + 512 * i, r = id >> 5, ch = id & 31;
            pq[i] = *(const u32x4*)(QK + (rb + r) * 2048 + hh * 256 + ch * 8); pkk[i] = *(const u32x4*)(QK + (rb + r) * 2048 + 1024 + hh * 256 + ch * 8); }
        pvv = *(const u32x4*)(V + (rb + vr) * 2048 + hh * 512 + slice * 64 + vc * 8);
#pragma unroll 1
        for (int c = 0; c < 64; ++c) {
#pragma unroll
            for (int i = 0; i < 4; ++i) { const int id = t + 512 * i, r = id >> 5, ch = id & 31;
                *(LAS u32x4*)(lds + Q_OFF + r * QP + ch * 16) = pq[i]; *(LAS u32x4*)(lds + K_OFF + r * QP + ch * 16) = pkk[i]; }
            *(LAS u32x4*)(lds + V_OFF + vr * VP + vc * 16) = pvv;
            __syncthreads();
            if (c + 1 < 64) { const size_t r1 = rb + (size_t)(c + 1) * 64;
#pragma unroll
                for (int i = 0; i < 4; ++i) { const int id = t + 512 * i, r = id >> 5, ch = id & 31;
                    pq[i] = *(const u32x4*)(QK + (r1 + r) * 2048 + hh * 256 + ch * 8); pkk[i] = *(const u32x4*)(QK + (r1 + r) * 2048 + 1024 + hh * 256 + ch * 8); }
                pvv = *(const u32x4*)(V + (r1 + vr) * 2048 + hh * 512 + slice * 64 + vc * 8); }
            const size_t r0 = rb + (size_t)c * 64;
            f32x16 acc;
#pragma unroll
            for (int i = 0; i < 16; ++i) acc[i] = 0.f;
            if (wave < 4) {
                const int mblk = wave >> 1, nblk = wave & 1, n = nblk * 32 + q32;
#pragma unroll 4
                for (int ks = 0; ks < 16; ++ks) {
                    const bf16x8 a = *(const LAS bf16x8*)(lds + K_OFF + (mblk * 32 + q32) * QP + ks * 32 + hf * 16);
                    const bf16x8 bq = *(const LAS bf16x8*)(lds + Q_OFF + n * QP + ks * 32 + hf * 16);
                    acc = __builtin_amdgcn_mfma_f32_32x32x16_bf16(a, bq, acc, 0, 0, 0);
                }
#pragma unroll
                for (int i = 0; i < 16; ++i) acc[i] *= dec[i];
#pragma unroll
                for (int j = 0; j < 4; ++j) { u32x2 w; w.x = cvt_pk_bf16(acc[4 * j], acc[4 * j + 1]); w.y = cvt_pk_bf16(acc[4 * j + 2], acc[4 * j + 3]);
                    *(LAS u32x2*)(lds + S_OFF + n * SP + (mblk * 32 + 8 * j + 4 * hf) * 2) = w; }
            } else {
                const int w4 = wave - 4, dvblk = w4 >> 1, nblk = w4 & 1, n = nblk * 32 + q32;
#pragma unroll 4
                for (int ks = 0; ks < 16; ++ks) {
                    const bf16x8 a = *(const LAS bf16x8*)(lds + ST_OFF + (dvblk * 32 + q32) * QP + ks * 32 + hf * 16);
                    const bf16x8 bq = *(const LAS bf16x8*)(lds + Q_OFF + n * QP + ks * 32 + hf * 16);
                    acc = __builtin_amdgcn_mfma_f32_32x32x16_bf16(a, bq, acc, 0, 0, 0);
                }
                acc = acc * dec[0];
            }
            __syncthreads();
            {
#pragma unroll
                for (int a = 0; a < 2; ++a) st[a] = st[a] * g64;
#pragma unroll
                for (int ks = 0; ks < 4; ++ks) {
                    bf16x8 av[2], bk;
#pragma unroll
                    for (int vb = 0; vb < 2; ++vb) { const LAS unsigned char* p = lds + V_OFF + (16 * ks + trrow) * VP + vb * 64 + trcol; av[vb] = tr_pair(p, p + 4 * VP); }
                    { const LAS unsigned char* p = lds + K_OFF + (16 * ks + trrow) * QP + wave * 64 + trcol; bk = tr_pair(p, p + 4 * QP); }
#pragma unroll
                    for (int vb = 0; vb < 2; ++vb) st[vb] = __builtin_amdgcn_mfma_f32_32x32x16_bf16(av[vb], bk, st[vb], 0, 0, 0);
                }
#pragma unroll
                for (int vb = 0; vb < 2; ++vb)
#pragma unroll
                    for (int i = 0; i < 16; ++i) { const int dv = vb * 32 + 8 * (i >> 2) + 4 * hf + (i & 3);
                        *(LAS bf16_t*)(lds + ST_OFF + dv * QP + (wave * 32 + q32) * 2) = (bf16_t)(cvt_pk_bf16(st[vb][i], 0.f) & 0xffffu); }
            }
            if (wave >= 4) {
                const int w4 = wave - 4, dvblk = w4 >> 1, nblk = w4 & 1, n = nblk * 32 + q32;
#pragma unroll
                for (int ks = 0; ks < 4; ++ks) {
                    const LAS unsigned char* p = lds + V_OFF + (16 * ks + trrow) * VP + dvblk * 64 + trcol;
                    const bf16x8 a = tr_pair(p, p + 4 * VP);
                    const bf16x8 bs = *(const LAS bf16x8*)(lds + S_OFF + n * SP + (16 * ks + 8 * hf) * 2);
                    acc = __builtin_amdgcn_mfma_f32_32x32x16_bf16(a, bs, acc, 0, 0, 0);
                }
                float sq = 0.f;
#pragma unroll
                for (int i = 0; i < 16; ++i) sq += acc[i] * acc[i];
                sq += __shfl_xor(sq, 32);
                if (hf == 0) rssq[(r0 + n) * 64 + hh * 16 + slice * 2 + dvblk] = sq;
                bf16_t* op = V + (r0 + n) * 2048 + hh * 512 + slice * 64 + dvblk * 32 + 4 * hf;
#pragma unroll
                for (int j = 0; j < 4; ++j) { u32x2 w; w.x = cvt_pk_bf16(acc[4 * j], acc[4 * j + 1]); w.y = cvt_pk_bf16(acc[4 * j + 2], acc[4 * j + 3]); *(u32x2*)(op + 8 * j) = w; }
            }
            __syncthreads();
        }
    }
}

#define XB_TMO      128
#define XB_XCNT(j)  (256  + 64 * (j))
#define XB_XSUB(j)  (1280 + 64 * (j))
#define XB_XGEN(j)  (2304 + 64 * (j))
#define XB_TOP      3328
#define XB_TOPGEN   3392
#define XCD_BAR_WORDS 3456
#define XB_SPIN_CAP (1u << 18)

__device__ __forceinline__ unsigned xb_ld(unsigned* p)              { return __hip_atomic_load(p, __ATOMIC_RELAXED, __HIP_MEMORY_SCOPE_AGENT); }
__device__ __forceinline__ unsigned xb_add(unsigned* p, unsigned v) { return __hip_atomic_fetch_add(p, v, __ATOMIC_RELAXED, __HIP_MEMORY_SCOPE_AGENT); }
__device__ __forceinline__ unsigned xb_xcc_id() { return (unsigned)__builtin_amdgcn_s_getreg((3 << 11) | 20) & 0xFu; }
#define XB_SPIN(cond, bar) do { unsigned _sp = 0; while (cond) { __builtin_amdgcn_s_sleep(1); \
    if ((++_sp & 255u) == 0u) { if (xb_ld(&(bar)[XB_TMO])) break; if (_sp > XB_SPIN_CAP) { atomicAdd(&(bar)[XB_TMO], 1u); break; } } } } while (0)

struct XcdBarrier {
    unsigned* bar; unsigned x;
    volatile LAS unsigned* st;
};

__device__ __forceinline__ XcdBarrier xcd_barrier_post(unsigned* bar, volatile LAS unsigned* st) {
    XcdBarrier b; b.bar = bar; b.x = xb_xcc_id(); b.st = st;
    if (threadIdx.x == 0) (void)xb_add(&bar[XB_XCNT(b.x)], 1u);
    return b;
}
__device__ __forceinline__ void xcd_barrier_complete(unsigned* bar, unsigned x, unsigned& nloc, unsigned& nx) {
    const unsigned G = gridDim.x * gridDim.y * gridDim.z;
    unsigned sum, cnt, mine, sp = 0u;
    for (;;) {
        sum = 0u; cnt = 0u; mine = 0u;
#pragma unroll
        for (unsigned j = 0; j < 16; ++j) { const unsigned c = xb_ld(&bar[XB_XCNT(j)]); sum += c; cnt += (c > 0u) ? 1u : 0u; mine = (j == x) ? c : mine; }
        if (sum == G) break;
        __builtin_amdgcn_s_sleep(1);
        if ((++sp & 255u) == 0u) { if (xb_ld(&bar[XB_TMO])) break; if (sp > XB_SPIN_CAP) { atomicAdd(&bar[XB_TMO], 1u); break; } }
    }
    nloc = mine > 0u ? mine : 1u; nx = cnt > 0u ? cnt : 1u;
}

__device__ __forceinline__ void xcd_barrier(const XcdBarrier& b) {
    asm volatile("s_waitcnt vmcnt(0)" ::: "memory");
    __syncthreads();
    if (threadIdx.x == 0) {
        unsigned* bar = b.bar;
        __builtin_amdgcn_s_waitcnt(0);
        unsigned nloc = b.st[0], nx = b.st[1];
        if (nloc == 0u) { xcd_barrier_complete(bar, b.x, nloc, nx); b.st[0] = nloc; b.st[1] = nx; }
        const unsigned old = xb_add(&bar[XB_XSUB(b.x)], 1u);
        const unsigned gen = old / nloc;
        if (old + 1u == (gen + 1u) * nloc) {
            __builtin_amdgcn_fence(__ATOMIC_RELEASE, "agent");
            asm volatile("s_waitcnt vmcnt(0)" ::: "memory");
            const unsigned og = xb_add(&bar[XB_TOP], 1u);
            const unsigned tg = og / nx;
            if (og + 1u == (tg + 1u) * nx) xb_add(&bar[XB_TOPGEN], 1u);
            else XB_SPIN(xb_ld(&bar[XB_TOPGEN]) == tg, bar);
            __builtin_amdgcn_fence(__ATOMIC_ACQUIRE, "agent");
            xb_add(&bar[XB_XGEN(b.x)], 1u);
            asm volatile("s_waitcnt vmcnt(0)" ::: "memory");
        } else {
            XB_SPIN(xb_ld(&bar[XB_XGEN(b.x)]) == gen, bar);
            __builtin_amdgcn_fence(__ATOMIC_ACQUIRE, "agent");
            asm volatile("s_waitcnt vmcnt(0)" ::: "memory");
        }
    }
    __syncthreads();
}

#ifndef PHMASK
#define PHMASK 0xFFFFFF
#endif
#define PH(n) if constexpr (((PHMASK) >> (n)) & 1)
#ifndef DUPMASK
#define DUPMASK 0
#endif
#define DUP(n) for (int rep_ = 0; rep_ < 1 + (((DUPMASK) >> (n)) & 1); ++rep_)
__global__ void __launch_bounds__(NTHREADS, 2) fwd_megakernel(Params P) {
    extern __shared__ __attribute__((aligned(16))) unsigned char lds_raw[];
    LAS unsigned char* lds = (LAS unsigned char*)lds_raw;
    cg::grid_group grid = cg::this_grid();
    const int wave = __builtin_amdgcn_readfirstlane(threadIdx.x >> 6);
    unsigned char* ws = P.ws;
    const int G = gridDim.x, c = blockIdx.x;
    bf16_t* Wb = (bf16_t*)(ws + WS_W);
    float* SSQ = (float*)(ws + WS_SSQ);
    bf16_t* hbA = (bf16_t*)(ws + WS_HBA);
    bf16_t* hbB = (bf16_t*)P.out;
    unsigned char* R = ws + WS_R;
    float* h = P.out;

    { volatile LAS unsigned* stw = (volatile LAS unsigned*)(lds + LDS_BYTES - 64); if (threadIdx.x < 2) stw[threadIdx.x] = 0u; __syncthreads(); }
    const XcdBarrier xbar = xcd_barrier_post((unsigned*)(ws + WS_BAR), (volatile LAS unsigned*)(lds + LDS_BYTES - 64));
    PH(0) prologue(P, lds, wave);
    if (P.out == nullptr) grid.sync();
    xcd_barrier(xbar);

    {
    PH(1) { pg8::Gemm g{hbA, Wb + W_RIN, MT, 4096, 1024, 1024}; pg8::StaticOrder S; S.init(MT, 4096, G, c);
      EpiRope E{(bf16_t*)(R + R_QK), (bf16_t*)(R + R_V), SSQ + SQ_MIX0 * MT, (const float*)(ws + WS_ROPE_R), (const float*)(ws + WS_ROPE_R) + 4096 * 128};
      pg8::gemm_phase(lds, g, S, E, wave); }
    xcd_barrier(xbar);
    PH(2) ret_mfma(P, lds, wave);
    xcd_barrier(xbar);
    }
    PH(3) { pg8::Gemm g{hbA, Wb + W_RIN + (size_t)4096 * 1024, MT, 2048, 1024, 1024}; pg8::StaticOrder S; S.init(MT, 2048, G, c);
      EpiGateY E{(bf16_t*)(R + R_V), SSQ + SQ_MIX0 * MT, (const float*)(ws + WS_RSSQ), (const float*)(ws + WS_SMALL)};
      pg8::gemm_phase(lds, g, S, E, wave); }
    xcd_barrier(xbar);
    PH(4) { pg8::Gemm g{(const bf16_t*)(R + R_V), Wb + W_ROUT, MT, 1024, 2048, 2048}; pg8::StaticOrder S; S.init(MT, 1024, G, c);
      EpiResidual E{hbA, hbA, SSQ + SQ_MLP0 * MT, nullptr};
      pg8::gemm_phase(lds, g, S, E, wave); }
    xcd_barrier(xbar);

    PH(11) { { pg8::Gemm g{hbA, Wb + W_1 + (size_t)0 * 4194304, MT, 4096, 1024, 1024}; pg8::StaticOrder S; S.init(MT, 4096, G, c);
      EpiScale<1, false> E{(bf16_t*)(R + R_HID), 4096, nullptr, 0.f, nullptr, nullptr};
      pg8::gemm_phase(lds, g, S, E, wave); } }
    xcd_barrier(xbar);
    PH(12) { pg8::Gemm g{(const bf16_t*)(R + R_HID), Wb + W_2 + (size_t)0 * 4194304, MT, 1024, 4096, 4096}; pg8::StaticOrder S; S.init(MT, 1024, G, c);
      EpiResidual E{hbA, hbA, SSQ + SQ_PLE0 * MT, SSQ + SQ_MLP0 * MT};
      pg8::gemm_phase(lds, g, S, E, wave); }
    xcd_barrier(xbar);
    PH(13) { pg8::Gemm g{(const bf16_t*)(ws + WS_PB) + (size_t)0 * MT * 256, Wb + W_P + (size_t)0 * 262144, MT, 1024, 256, 256}; pg8::StaticOrder S; S.init(MT, 1024, G, c);
      EpiPlainNP E{(bf16_t*)(R + R_PP)};
      pg8::gemm_phase(lds, g, S, E, wave); }
    PH(14) { pg8::Gemm g{hbA, Wb + W_G + (size_t)0 * 1048576, MT, 1024, 1024, 1024}; pg8::StaticOrder S; S.init(MT, 1024, G, c);
      EpiPle E{hbA, (const bf16_t*)(R + R_PP), SSQ + SQ_PLE0 * MT, hbB, SSQ + SQ_MIX1 * MT, nullptr};
      pg8::gemm_phase(lds, g, S, E, wave); }
    xcd_barrier(xbar);
    PH(5) { pg8::Gemm g{hbB, Wb + W_MIN, MT, 768, 1024, 1024}; pg8::StaticOrder S; S.init(MT, 768, G, c);
      EpiScale<0, true> E{(bf16_t*)(R + R_CQKV), 768, SSQ + SQ_MIX1 * MT, 1.f / 1024.f, SSQ + SQ_CQ * MT, SSQ + SQ_CKV * MT};
      pg8::gemm_phase(lds, g, S, E, wave); }
    xcd_barrier(xbar);
    PH(6) { pg8::Gemm g{(const bf16_t*)(R + R_CQKV), Wb + W_UQ, MT, 1536, 384, 768}; pg8::StaticOrder S; S.init(MT, 1536, G, c);
      EpiScale<0, false> E{(bf16_t*)(R + R_Q), 1536, nullptr, 0.f, nullptr, nullptr};
      pg8::gemm_phase(lds, g, S, E, wave); }
    PH(7) { pg8::Gemm g{(const bf16_t*)(R + R_CQKV) + 384, Wb + W_UKV, MT, 2560, 256, 768}; pg8::StaticOrder S; S.init(MT, 2560, G, c);
      EpiScale<0, false> E{(bf16_t*)(R + R_KV), 2560, SSQ + SQ_CKV * MT, 1.f / 256.f, nullptr, nullptr};
      pg8::gemm_phase(lds, g, S, E, wave); }
    xcd_barrier(xbar);
    PH(8) mla_finalize(P, wave);
    xcd_barrier(xbar);
    PH(9) att_mfma(P, lds, wave);
    xcd_barrier(xbar);
    PH(10) { pg8::Gemm g{(const bf16_t*)(R + R_O), Wb + W_MOUT, MT, 1024, 1024, 1024}; pg8::StaticOrder S; S.init(MT, 1024, G, c);
      EpiResidual E{hbB, hbA, SSQ + SQ_MLP1 * MT, nullptr};
      pg8::gemm_phase(lds, g, S, E, wave); }
    xcd_barrier(xbar);
    PH(11) { pg8::Gemm g{hbA, Wb + W_1 + (size_t)1 * 4194304, MT, 4096, 1024, 1024}; pg8::StaticOrder S; S.init(MT, 4096, G, c);
      EpiScale<1, false> E{(bf16_t*)(R + R_HID), 4096, nullptr, 0.f, nullptr, nullptr};
      pg8::gemm_phase(lds, g, S, E, wave); }
    xcd_barrier(xbar);
    PH(12) { pg8::Gemm g{(const bf16_t*)(R + R_HID), Wb + W_2 + (size_t)1 * 4194304, MT, 1024, 4096, 4096}; pg8::StaticOrder S; S.init(MT, 1024, G, c);
      EpiResidual E{hbA, hbA, SSQ + SQ_PLE1 * MT, SSQ + SQ_MLP1 * MT};
      pg8::gemm_phase(lds, g, S, E, wave); }
    xcd_barrier(xbar);
    PH(13) { pg8::Gemm g{(const bf16_t*)(ws + WS_PB) + (size_t)1 * MT * 256, Wb + W_P + (size_t)1 * 262144, MT, 1024, 256, 256}; pg8::StaticOrder S; S.init(MT, 1024, G, c);
      EpiPlainNP E{(bf16_t*)(R + R_PP)};
      pg8::gemm_phase(lds, g, S, E, wave); }
    PH(14) { pg8::Gemm g{hbA, Wb + W_G + (size_t)1 * 1048576, MT, 1024, 1024, 1024}; pg8::StaticOrder S; S.init(MT, 1024, G, c);
      EpiPle E{hbA, (const bf16_t*)(R + R_PP), SSQ + SQ_PLE1 * MT, nullptr, nullptr, h};
      pg8::gemm_phase(lds, g, S, E, wave); }
#ifdef SYNCPROBE
    for (int i_ = 0; i_ < 8; ++i_) xcd_barrier(xbar);
#endif
}

extern "C" void kernel_launch(void* const* d_in, const int* in_sizes, int n_in, void* d_out, int out_size, void* d_ws, size_t ws_size, hipStream_t stream) {
    static int grid_blocks = 0;
    if (grid_blocks == 0) {
        if (n_in != 20 || out_size != MT * DM || ws_size < WS_END) { fprintf(stderr, "kernel_launch: unexpected shapes (n_in %d out %d ws %zu)\n", n_in, out_size, ws_size); grid_blocks = -1; return; }
        int dev = 0, cus = 0, per_cu = 0;
        hipGetDevice(&dev);
        hipDeviceGetAttribute(&cus, hipDeviceAttributeMultiprocessorCount, dev);
        if (hipFuncSetAttribute((const void*)fwd_megakernel, hipFuncAttributeMaxDynamicSharedMemorySize, LDS_BYTES) != hipSuccess) { fprintf(stderr, "kernel_launch: hipFuncSetAttribute failed\n"); grid_blocks = -1; return; }
        hipOccupancyMaxActiveBlocksPerMultiprocessor(&per_cu, (const void*)fwd_megakernel, NTHREADS, LDS_BYTES);
        if (per_cu < 1) { fprintf(stderr, "kernel_launch: occupancy query says %d blocks per CU\n", per_cu); grid_blocks = -1; return; }
        grid_blocks = cus * per_cu;
    }
    if (grid_blocks < 0) return;
    if (hipMemsetAsync((char*)d_ws + WS_BAR, 0, 16384, stream) != hipSuccess) { fprintf(stderr, "kernel_launch: memset failed\n"); return; }
    Params p{};
    for (int i = 0; i < 20; ++i) p.in[i] = (const float*)d_in[i];
    p.out = (float*)d_out; p.ws = (unsigned char*)d_ws;
    void* args[] = {&p};
    hipError_t e = hipLaunchCooperativeKernel((const void*)fwd_megakernel, dim3(grid_blocks), dim3(NTHREADS), args, LDS_BYTES, stream);
    if (e != hipSuccess) fprintf(stderr, "cooperative launch failed: %s (grid %d)\n", hipGetErrorString(e), grid_blocks);
}
```

```cpp
#include <hip/hip_runtime.h>
#include <hip/hip_cooperative_groups.h>
#include <cstdio>
#include <cstdint>
namespace cg = cooperative_groups;

#define LAS __attribute__((address_space(3)))
typedef unsigned short bf16_t;
typedef short bf16x8 __attribute__((ext_vector_type(8)));
typedef float f32x4 __attribute__((ext_vector_type(4)));
typedef float f32x2 __attribute__((ext_vector_type(2)));
typedef unsigned u32x4 __attribute__((ext_vector_type(4)));
typedef unsigned u32x2 __attribute__((ext_vector_type(2)));


constexpr int MT = 32768, SEQ = 4096, DM = 1024, FF = 4096, PLE = 256;
constexpr float EPS = 1e-6f;
constexpr int NTHREADS = 512, NWAVES = 8;
constexpr int LDS_BYTES = 160 * 1024;

constexpr size_t MiB = 1u << 20;
constexpr size_t WS_SSQ = 0;
constexpr size_t WS_RSSQ = 496 * MiB;
constexpr size_t WS_ROPE_R = 5 * MiB;
constexpr size_t WS_ROPE_M = 9 * MiB;
constexpr size_t WS_SMALL = 10 * MiB;
constexpr size_t WS_BAR = 12 * MiB;
constexpr size_t WS_W = 16 * MiB;
constexpr size_t WS_PB = 80 * MiB;
constexpr size_t WS_HBA = 112 * MiB;
constexpr size_t WS_R = 176 * MiB;
constexpr size_t WS_END = 512 * MiB;
constexpr size_t R_QK = 0;
constexpr size_t R_V = 128 * MiB;
constexpr size_t R_HID = 0;
constexpr size_t R_PP = 160 * MiB;
constexpr size_t R_HBB = 64 * MiB;
constexpr size_t R_CQKV = 0;
constexpr size_t R_O = 0;
constexpr size_t R_Q = 64 * MiB;
constexpr size_t R_KV = 160 * MiB;
constexpr size_t W_RIN = 0, W_ROUT = 6291456, W_MIN = 8388608, W_UQ = 9175040, W_UKV = 9764864, W_MOUT = 10420224,
                 W_1 = 11468800, W_2 = 19857408, W_G = 28246016, W_P = 30343168;
enum { SQ_MIX0 = 0, SQ_MLP0, SQ_PLE0, SQ_MIX1, SQ_MLP1, SQ_PLE1, SQ_CQ, SQ_CKV };

struct Params {
    const float* in[20];
    float* out;
    unsigned char* ws;
};

__device__ __forceinline__ unsigned f2bf(float f) { unsigned u = __builtin_bit_cast(unsigned, f); return (u + 0x7fffu + ((u >> 16) & 1u)) >> 16; }
typedef __bf16 bf16x2_t __attribute__((ext_vector_type(2)));
__device__ __forceinline__ unsigned cvt_pk_bf16(float lo, float hi) { f32x2 v = {lo, hi}; bf16x2_t b = __builtin_convertvector(v, bf16x2_t); return __builtin_bit_cast(unsigned, b); }
__device__ __forceinline__ unsigned pk2(float lo, float hi) { return cvt_pk_bf16(lo, hi); }
__device__ __forceinline__ float bf2f(unsigned short b) { return __builtin_bit_cast(float, (unsigned)b << 16); }
__device__ __forceinline__ float bflo(unsigned w) { return __builtin_bit_cast(float, w << 16); }
__device__ __forceinline__ float bfhi(unsigned w) { return __builtin_bit_cast(float, w & 0xffff0000u); }
__device__ __forceinline__ int lane_id_asm() { int l; asm volatile("v_mbcnt_lo_u32_b32 %0, -1, 0\n\tv_mbcnt_hi_u32_b32 %0, -1, %0" : "=v"(l)); return l; }
__device__ __forceinline__ float wave_sum(float v) {
#pragma unroll
    for (int o = 1; o < 64; o <<= 1) v += __shfl_xor(v, o);
    return v;
}
__device__ __forceinline__ float wave_max(float v) {
#pragma unroll
    for (int o = 1; o < 64; o <<= 1) v = fmaxf(v, __shfl_xor(v, o));
    return v;
}

namespace pg8 {
constexpr int BM = 256, BK = 64, HALF = 128, HTB = HALF * BK * 2, STAGE_BYTES = 8 * HTB, NXCD = 8, WGM = 4;
__device__ __forceinline__ int lds_byte(int r, int c) { const int st = (r >> 4) * 2 + (c >> 5), rr = r & 15, cc = c & 31, ob = rr * 64 + cc * 2; return st * 1024 + (ob ^ (((ob >> 9) & 1) << 5)); }
__device__ __forceinline__ void stage_rc(int b, int& R, int& C) { const int st = b / 1024, sb = b % 1024, swz = sb ^ (((sb >> 9) & 1) << 5); R = (st >> 1) * 16 + swz / 64; C = (st & 1) * 32 + (swz % 64) / 2; }
__device__ __forceinline__ int perm32(int rho) { const int n = rho >> 4, i = rho & 15; return 8 * (i >> 2) + 4 * n + (i & 3); }

struct Unit { int pm, pn; };
struct Gemm { const bf16_t* A; const bf16_t* Bt; int M, N, K, lda; };

struct StaticOrder {
    int nM, nN, nwg, G, c; bool rev;
    __device__ void init(int M, int N, int G_, int c_, bool rev_ = false) { nM = M / BM; nN = N / BM; nwg = nM * nN; G = G_; c = c_; rev = rev_; }
    __device__ bool next(int i, Unit& u) const {
        long L = (long)i * G + c; if (L >= nwg) return false;
        if (rev) L = nwg - 1 - L;
        int wgid = (int)L; { const int q = nwg / NXCD, r = nwg % NXCD, xcd = wgid % NXCD, off = wgid / NXCD; wgid = (xcd < r ? xcd * (q + 1) : r * (q + 1) + (xcd - r) * q) + off; }
        const int nig = WGM * nN, gid = wgid / nig, fm = gid * WGM, gsz = (nM - fm) < WGM ? (nM - fm) : WGM;
        u.pm = fm + ((wgid % nig) % gsz); u.pn = (wgid % nig) / gsz; return true;
    }
};

template <class Epi>
__device__ __forceinline__ void gemm_phase(LAS unsigned char* lds, const Gemm g, const StaticOrder& S, const Epi& E, const int wid) {
    const int lane = lane_id_asm(), tid = wid * 64 + lane, wr = wid >> 2, wc = wid & 3, fr = lane & 15, fq = lane >> 4;
    const int K = g.K, nt = K / BK, lda = g.lda;
    unsigned voffA[2], voffB[2];
#pragma unroll
    for (int i = 0; i < 2; ++i) { int R, C; stage_rc(tid * 16 + i * 8192, R, C); const int Rb = Epi::PERM ? ((R & ~31) + perm32(R & 31)) : R;
        voffA[i] = (unsigned)(R * lda + C) * 2u; voffB[i] = (unsigned)(Rb * K + C) * 2u; }
    const size_t kstep = (size_t)(BK * 2);
    const size_t hsA = (size_t)HALF * lda * 2, hsB = (size_t)HALF * K * 2;
    const size_t tsA = 2 * hsA, tsB = 2 * hsB;
    const unsigned ldsw = (unsigned)wid * 1024u;
    const int aoff = lds_byte(wr * 64 + fr, fq * 8), boff = lds_byte(wc * 32 + fr, fq * 8);
#define PG8_SA(b, h) (((b) * 2 + (h)) * HTB)
#define PG8_SB(b, h) ((4 + (b) * 2 + (h)) * HTB)
#define PG8_STAGE(bufoff, gbase, voff) do { _Pragma("unroll") for (int _i = 0; _i < 2; ++_i) \
        __builtin_amdgcn_global_load_lds((const unsigned*)((const char*)(gbase) + (voff)[_i]), (LAS unsigned*)(lds + (bufoff) + ldsw + _i * 8192), 16, 0, 0); } while (0)
#define PG8_LDA(dst, b, h) do { _Pragma("unroll") for (int m = 0; m < 4; ++m) _Pragma("unroll") for (int k = 0; k < 2; ++k) dst[m][k] = *(const LAS bf16x8*)(lds + PG8_SA(b, h) + aoff + m * 2048 + k * 1024); } while (0)
#define PG8_LDB(dst, b, h) do { _Pragma("unroll") for (int n = 0; n < 2; ++n) _Pragma("unroll") for (int k = 0; k < 2; ++k) dst[n][k] = *(const LAS bf16x8*)(lds + PG8_SB(b, h) + boff + n * 2048 + k * 1024); } while (0)
#define PG8_MMA(ai, bj, At, Bt) do { __builtin_amdgcn_s_setprio(1); _Pragma("unroll") for (int m = 0; m < 4; ++m) _Pragma("unroll") for (int n = 0; n < 2; ++n) _Pragma("unroll") for (int k = 0; k < 2; ++k) \
        acc[ai][bj][m][n] = __builtin_amdgcn_mfma_f32_16x16x32_bf16(Bt[n][k], At[m][k], acc[ai][bj][m][n], 0, 0, 0); __builtin_amdgcn_s_setprio(0); } while (0)
#define PG8_WAIT_V(n) asm volatile("s_waitcnt vmcnt(" #n ")" ::: "memory")
#define PG8_WAIT_L(n) asm volatile("s_waitcnt lgkmcnt(" #n ")" ::: "memory")
#define PG8_BAR __builtin_amdgcn_s_barrier()
#define PG8_SCHED __builtin_amdgcn_sched_barrier(0)
    Unit cur, nxt; int ui = 0;
    if (!S.next(0, cur)) return;
    f32x4 acc[2][2][4][2];
#pragma unroll
    for (int a = 0; a < 2; ++a)
#pragma unroll
        for (int b = 0; b < 2; ++b)
#pragma unroll
            for (int m = 0; m < 4; ++m)
#pragma unroll
                for (int n = 0; n < 2; ++n) acc[a][b][m][n] = (f32x4){0.f, 0.f, 0.f, 0.f};
    bf16x8 At[4][2], B0[2][2], B1[2][2];
    const char* cA = (const char*)g.A + (size_t)cur.pm * tsA; const char* cB = (const char*)g.Bt + (size_t)cur.pn * tsB;
    PG8_STAGE(PG8_SB(0, 0), cB, voffB); PG8_STAGE(PG8_SB(0, 1), cB + hsB, voffB); PG8_STAGE(PG8_SA(0, 0), cA, voffA); PG8_STAGE(PG8_SA(0, 1), cA + hsA, voffA);
    if (wr == 1) PG8_BAR;
    PG8_WAIT_V(2); PG8_BAR;
    PG8_STAGE(PG8_SB(1, 0), cB + kstep, voffB); PG8_STAGE(PG8_SA(1, 0), cA + kstep, voffA); PG8_STAGE(PG8_SB(1, 1), cB + hsB + kstep, voffB);
    PG8_WAIT_V(6); PG8_BAR;
    for (;;) {
        const bool has_next = S.next(ui + 1, nxt);
        const char* nA = has_next ? (const char*)g.A + (size_t)nxt.pm * tsA : cA; const char* nB = has_next ? (const char*)g.Bt + (size_t)nxt.pn * tsB : cB;
#pragma unroll 1
        for (int t = 0; t < nt; t += 2) {
            const bool last = (t == nt - 2);
            const char* a1 = cA + (size_t)(t + 1) * kstep;
            const char* a2 = last ? nA : cA + (size_t)(t + 2) * kstep; const char* b2 = last ? nB : cB + (size_t)(t + 2) * kstep;
            const char* a3 = a2 + kstep; const char* b3 = b2 + kstep;
            PG8_LDB(B0, 0, 0); PG8_LDB(B1, 0, 1); PG8_SCHED; PG8_LDA(At, 0, 0); PG8_STAGE(PG8_SA(1, 1), a1 + hsA, voffA);
            PG8_WAIT_V(8); PG8_WAIT_L(0); PG8_BAR; PG8_MMA(0, 0, At, B0); PG8_MMA(0, 1, At, B1); PG8_BAR; PG8_SCHED;
            PG8_LDA(At, 0, 1); PG8_STAGE(PG8_SB(0, 0), b2, voffB); PG8_STAGE(PG8_SB(0, 1), b2 + hsB, voffB); PG8_STAGE(PG8_SA(0, 0), a2, voffA);
            PG8_WAIT_V(8); PG8_WAIT_L(0); PG8_BAR; PG8_MMA(1, 0, At, B0); PG8_MMA(1, 1, At, B1); PG8_BAR; PG8_SCHED;
            PG8_LDB(B0, 1, 0); PG8_LDB(B1, 1, 1); PG8_SCHED; PG8_LDA(At, 1, 0); PG8_STAGE(PG8_SA(0, 1), a2 + hsA, voffA);
            PG8_WAIT_V(8); PG8_WAIT_L(0); PG8_BAR; PG8_MMA(0, 0, At, B0); PG8_MMA(0, 1, At, B1); PG8_BAR; PG8_SCHED;
            PG8_LDA(At, 1, 1); PG8_STAGE(PG8_SB(1, 0), b3, voffB); PG8_STAGE(PG8_SB(1, 1), b3 + hsB, voffB); PG8_STAGE(PG8_SA(1, 0), a3, voffA);
            PG8_WAIT_V(8); PG8_WAIT_L(0); PG8_BAR; PG8_MMA(1, 0, At, B0); PG8_MMA(1, 1, At, B1); PG8_BAR; PG8_SCHED;
        }
        if (wr == 0) PG8_BAR;
        E(acc, cur, wid);
        if (!has_next) break;
#pragma unroll
        for (int a = 0; a < 2; ++a)
#pragma unroll
            for (int b = 0; b < 2; ++b)
#pragma unroll
                for (int m = 0; m < 4; ++m)
#pragma unroll
                    for (int n = 0; n < 2; ++n) acc[a][b][m][n] = (f32x4){0.f, 0.f, 0.f, 0.f};
        cur = nxt; cA = nA; cB = nB; ++ui;
        if (wr == 1) PG8_BAR;
    }
    PG8_WAIT_V(0);
    PG8_BAR;
#undef PG8_SA
#undef PG8_SB
#undef PG8_STAGE
#undef PG8_LDA
#undef PG8_LDB
#undef PG8_MMA
#undef PG8_WAIT_V
#undef PG8_WAIT_L
#undef PG8_BAR
#undef PG8_SCHED
}
}

typedef f32x4 Acc[2][2][4][2];
__device__ __forceinline__ float rstd_of(const float* ssq, int row, float inv_n) { return __builtin_amdgcn_rsqf(ssq[row] * inv_n + EPS); }
__device__ __forceinline__ u32x4 pack8(f32x4 a, f32x4 b) { u32x4 w; w.x = pk2(a[0], a[1]); w.y = pk2(a[2], a[3]); w.z = pk2(b[0], b[1]); w.w = pk2(b[2], b[3]); return w; }

template <int ACT  , bool SSQP>
struct EpiScale {
    static constexpr bool PERM = true;
    bf16_t* O; int ldc; const float* ssq; float inv_n; float* ssqA; float* ssqB;
    __device__ __forceinline__ void operator()(const Acc& acc, const pg8::Unit& u, int wid) const {
        const int lane_ = lane_id_asm(), wr = wid >> 2, wc = wid & 3, fr = lane_ & 15, fq = lane_ >> 4;
        const int row0 = u.pm * 256 + wr * 64 + fr, col0 = u.pn * 256 + wc * 32 + 8 * fq;
        float scv[8];
#pragma unroll
        for (int i = 0; i < 8; ++i) scv[i] = ssq ? ssq[row0 + (i >> 2) * 128 + (i & 3) * 16] : 0.f;
#pragma unroll
        for (int ai = 0; ai < 2; ++ai)
#pragma unroll
            for (int m = 0; m < 4; ++m) {
                const int row = row0 + ai * 128 + m * 16;
                const float sc = ssq ? __builtin_amdgcn_rsqf(scv[ai * 4 + m] * inv_n + EPS) : 1.f;
#pragma unroll
                for (int bj = 0; bj < 2; ++bj) {
                    f32x4 v0 = acc[ai][bj][m][0] * sc, v1 = acc[ai][bj][m][1] * sc;
                    if (ACT == 1) {
#pragma unroll
                        for (int e = 0; e < 4; ++e) { float a = fmaxf(v0[e], 0.f), b = fmaxf(v1[e], 0.f); v0[e] = a * a; v1[e] = b * b; }
                    }
                    *(u32x4*)(O + (size_t)row * ldc + col0 + bj * 128) = pack8(v0, v1);
                    if (SSQP) {
                        float s = 0.f;
#pragma unroll
                        for (int e = 0; e < 4; ++e) s += v0[e] * v0[e] + v1[e] * v1[e];
                        s += __shfl_xor(s, 16); s += __shfl_xor(s, 32);
                        const int hidx = 2 * u.pn + bj;
                        if (fq == 0 && hidx < 5) atomicAdd((hidx < 3 ? ssqA : ssqB) + row, s);
                    }
                }
            }
    }
};

struct EpiRope {
    static constexpr bool PERM = true;
    bf16_t* QK; bf16_t* V; const float* ssq; const float* cosT; const float* sinT;
    __device__ __forceinline__ void operator()(const Acc& acc, const pg8::Unit& u, int wid) const {
        const int lane_ = lane_id_asm(), wr = wid >> 2, wc = wid & 3, fr = lane_ & 15, fq = lane_ >> 4;
        const int row0 = u.pm * 256 + wr * 64 + fr, colL = wc * 32 + 8 * fq, pn = u.pn;
        float scv[8];
#pragma unroll
        for (int i = 0; i < 8; ++i) scv[i] = ssq[row0 + (i >> 2) * 128 + (i & 3) * 16];
        if (pn < 8) {
            const float kmul = pn >= 4 ? 0.0625f : 1.f;
#pragma unroll
            for (int ai = 0; ai < 2; ++ai)
#pragma unroll
                for (int mp = 0; mp < 2; ++mp) {
                    f32x4 c4[2][2], s4[2][2];
#pragma unroll
                    for (int mm = 0; mm < 2; ++mm) { const int s = (row0 + ai * 128 + (2 * mp + mm) * 16) & (SEQ - 1);
#pragma unroll
                        for (int n = 0; n < 2; ++n) { c4[mm][n] = *(const f32x4*)(cosT + (size_t)s * 128 + colL + 4 * n); s4[mm][n] = *(const f32x4*)(sinT + (size_t)s * 128 + colL + 4 * n); } }
#pragma unroll
                    for (int mm = 0; mm < 2; ++mm) { const int m = 2 * mp + mm, row = row0 + ai * 128 + m * 16;
                        const float ks = __builtin_amdgcn_rsqf(scv[ai * 4 + m] * (1.f / 1024.f) + EPS) * kmul;
                        f32x4 o1[2], o2[2];
#pragma unroll
                        for (int n = 0; n < 2; ++n) { const f32x4 x1 = acc[ai][0][m][n] * ks, x2 = acc[ai][1][m][n] * ks;
                            o1[n] = x1 * c4[mm][n] - x2 * s4[mm][n]; o2[n] = x2 * c4[mm][n] + x1 * s4[mm][n]; }
                        bf16_t* p = QK + (size_t)row * 2048 + pn * 256 + colL;
                        *(u32x4*)p = pack8(o1[0], o1[1]); *(u32x4*)(p + 128) = pack8(o2[0], o2[1]); }
                }
        } else {
            const float lgh = __builtin_amdgcn_logf(1.f - __builtin_amdgcn_exp2f(-5.f - (float)((pn - 8) >> 1)));
#pragma unroll
            for (int ai = 0; ai < 2; ++ai)
#pragma unroll
                for (int m = 0; m < 4; ++m) { const int row = row0 + ai * 128 + m * 16;
                    const float sc = __builtin_amdgcn_rsqf(scv[ai * 4 + m] * (1.f / 1024.f) + EPS) * __builtin_amdgcn_exp2f(lgh * (float)(63 - (row & 63)));
                    bf16_t* p = V + (size_t)row * 2048 + (pn - 8) * 256 + colL;
#pragma unroll
                    for (int bj = 0; bj < 2; ++bj) *(u32x4*)(p + bj * 128) = pack8(acc[ai][bj][m][0] * sc, acc[ai][bj][m][1] * sc); }
        }
    }
};

struct EpiGateY {
    static constexpr bool PERM = true;
    bf16_t* Y; const float* ssq; const float* rssq; const float* gn;
    __device__ __forceinline__ void operator()(const Acc& acc, const pg8::Unit& u, int wid) const {
        const int lane_ = lane_id_asm(), wr = wid >> 2, wc = wid & 3, fr = lane_ & 15, fq = lane_ >> 4;
        const int row0 = u.pm * 256 + wr * 64 + fr, col0 = u.pn * 256 + wc * 32 + 8 * fq, head = u.pn >> 1;
        f32x4 g4[2][2];
#pragma unroll
        for (int bj = 0; bj < 2; ++bj) { g4[bj][0] = *(const f32x4*)(gn + col0 + bj * 128); g4[bj][1] = *(const f32x4*)(gn + col0 + bj * 128 + 4); }
#pragma unroll
        for (int ai = 0; ai < 2; ++ai)
#pragma unroll
            for (int mp = 0; mp < 2; ++mp) {
                float scv[2]; f32x4 rq[2][4]; u32x4 ov[2][2];
#pragma unroll
                for (int mm = 0; mm < 2; ++mm) { const int row = row0 + ai * 128 + (2 * mp + mm) * 16;
                    scv[mm] = ssq[row];
                    const f32x4* rp = (const f32x4*)(rssq + (size_t)row * 64 + head * 16);
#pragma unroll
                    for (int i = 0; i < 4; ++i) rq[mm][i] = rp[i];
#pragma unroll
                    for (int bj = 0; bj < 2; ++bj) ov[mm][bj] = *(const u32x4*)(Y + (size_t)row * 2048 + col0 + bj * 128); }
#pragma unroll
                for (int mm = 0; mm < 2; ++mm) { const int m = 2 * mp + mm, row = row0 + ai * 128 + m * 16;
                    const float sc = __builtin_amdgcn_rsqf(scv[mm] * (1.f / 1024.f) + EPS);
                    const f32x4 pa = (rq[mm][0] + rq[mm][1]) + (rq[mm][2] + rq[mm][3]);
                    const float rg = __builtin_amdgcn_rsqf(((pa[0] + pa[1]) + (pa[2] + pa[3])) * (1.f / 512.f) + EPS);
#pragma unroll
                    for (int bj = 0; bj < 2; ++bj) {
                        const u32x4 w = ov[mm][bj];
                        f32x4 o0 = (f32x4){bflo(w.x), bfhi(w.x), bflo(w.y), bfhi(w.y)}, o1 = (f32x4){bflo(w.z), bfhi(w.z), bflo(w.w), bfhi(w.w)};
                        f32x4 a0 = acc[ai][bj][m][0] * sc, a1 = acc[ai][bj][m][1] * sc;
#pragma unroll
                        for (int e = 0; e < 4; ++e) { a0[e] = a0[e] * __builtin_amdgcn_rcpf(1.f + __builtin_amdgcn_exp2f(-1.4426950408889634f * a0[e])); a1[e] = a1[e] * __builtin_amdgcn_rcpf(1.f + __builtin_amdgcn_exp2f(-1.4426950408889634f * a1[e])); }
                        o0 = a0 * o0 * g4[bj][0] * rg; o1 = a1 * o1 * g4[bj][1] * rg;
                        *(u32x4*)(Y + (size_t)row * 2048 + col0 + bj * 128) = pack8(o0, o1);
                    } }
            }
    }
};

struct EpiResidual {
    static constexpr bool PERM = true;
    const bf16_t* base; bf16_t* hb; float* ssq_out; const float* ssq2;
    __device__ __forceinline__ void operator()(const Acc& acc, const pg8::Unit& u, int wid) const {
        const int lane_ = lane_id_asm(), wr = wid >> 2, wc = wid & 3, fr = lane_ & 15, fq = lane_ >> 4;
        const int row0 = u.pm * 256 + wr * 64 + fr, col0 = u.pn * 256 + wc * 32 + 8 * fq;
        float r2[8];
#pragma unroll
        for (int i = 0; i < 8; ++i) r2[i] = ssq2 ? ssq2[row0 + (i >> 2) * 128 + (i & 3) * 16] : 0.f;
        u32x4 bv[2][4][2];
#pragma unroll
        for (int ai = 0; ai < 2; ++ai)
#pragma unroll
            for (int m = 0; m < 4; ++m)
#pragma unroll
                for (int bj = 0; bj < 2; ++bj) bv[ai][m][bj] = *(const u32x4*)(base + (size_t)(row0 + ai * 128 + m * 16) * 1024 + col0 + bj * 128);
#pragma unroll
        for (int ai = 0; ai < 2; ++ai) {
#pragma unroll
            for (int m = 0; m < 4; ++m) {
                const int row = row0 + ai * 128 + m * 16; float sq = 0.f;
                const float rr = ssq2 ? __builtin_amdgcn_rcpf(r2[ai * 4 + m] * (1.f / 1024.f) + EPS) : 1.f;
#pragma unroll
                for (int bj = 0; bj < 2; ++bj) {
                    const u32x4 b4 = bv[ai][m][bj];
                    const f32x4 o0 = (f32x4){bflo(b4.x), bfhi(b4.x), bflo(b4.y), bfhi(b4.y)} + acc[ai][bj][m][0] * rr;
                    const f32x4 o1 = (f32x4){bflo(b4.z), bfhi(b4.z), bflo(b4.w), bfhi(b4.w)} + acc[ai][bj][m][1] * rr;
                    *(u32x4*)(hb + (size_t)row * 1024 + col0 + bj * 128) = pack8(o0, o1);
                    sq += (o0[0] * o0[0] + o0[1] * o0[1]) + (o0[2] * o0[2] + o0[3] * o0[3]) + (o1[0] * o1[0] + o1[1] * o1[1]) + (o1[2] * o1[2] + o1[3] * o1[3]);
                }
                if (ssq_out) { sq += __shfl_xor(sq, 16); sq += __shfl_xor(sq, 32); if (fq == 0) atomicAdd(ssq_out + row, sq); }
            }
        }
    }
};

struct EpiPlainNP {
    static constexpr bool PERM = true;
    bf16_t* O;
    __device__ __forceinline__ void operator()(const Acc& acc, const pg8::Unit& u, int wid) const {
        const int lane_ = lane_id_asm(), wr = wid >> 2, wc = wid & 3, fr = lane_ & 15, fq = lane_ >> 4;
        const int row0 = u.pm * 256 + wr * 64 + fr, col0 = u.pn * 256 + wc * 32 + 8 * fq;
#pragma unroll
        for (int ai = 0; ai < 2; ++ai)
#pragma unroll
            for (int m = 0; m < 4; ++m)
#pragma unroll
                for (int bj = 0; bj < 2; ++bj) *(u32x4*)(O + (size_t)(row0 + ai * 128 + m * 16) * 1024 + col0 + bj * 128) = pack8(acc[ai][bj][m][0], acc[ai][bj][m][1]);
    }
};

struct EpiPle {
    static constexpr bool PERM = true;
    const bf16_t* hbase; const bf16_t* pp; const float* ssq; bf16_t* hb_out; float* ssq_out; float* fout;
    __device__ __forceinline__ void operator()(const Acc& acc, const pg8::Unit& u, int wid) const {
        const int lane_ = lane_id_asm(), wr = wid >> 2, wc = wid & 3, fr = lane_ & 15, fq = lane_ >> 4;
        const int row0 = u.pm * 256 + wr * 64 + fr, col0 = u.pn * 256 + wc * 32 + 8 * fq;
#pragma unroll
        for (int ai = 0; ai < 2; ++ai)
#pragma unroll
            for (int mp = 0; mp < 2; ++mp) {
                u32x4 hv[2][2], pw[2][2]; float scv[2];
#pragma unroll
                for (int mm = 0; mm < 2; ++mm) {
                    const int row = row0 + ai * 128 + (2 * mp + mm) * 16;
                    scv[mm] = ssq[row];
#pragma unroll
                    for (int bj = 0; bj < 2; ++bj) { const size_t off = (size_t)row * 1024 + col0 + bj * 128; hv[mm][bj] = *(const u32x4*)(hbase + off); pw[mm][bj] = *(const u32x4*)(pp + off); }
                }
#pragma unroll
                for (int mm = 0; mm < 2; ++mm) {
                    const int m = 2 * mp + mm, row = row0 + ai * 128 + m * 16; float sq = 0.f;
                    const float sc = __builtin_amdgcn_rsqf(scv[mm] * (1.f / 1024.f) + EPS);
#pragma unroll
                    for (int bj = 0; bj < 2; ++bj) {
                        const size_t off = (size_t)row * 1024 + col0 + bj * 128;
                        const u32x4 pwv = pw[mm][bj], hw = hv[mm][bj];
                        const f32x4 p0 = (f32x4){bflo(pwv.x), bfhi(pwv.x), bflo(pwv.y), bfhi(pwv.y)}, p1 = (f32x4){bflo(pwv.z), bfhi(pwv.z), bflo(pwv.w), bfhi(pwv.w)};
                        f32x4 g0 = acc[ai][bj][m][0] * sc, g1 = acc[ai][bj][m][1] * sc;
#pragma unroll
                        for (int e = 0; e < 4; ++e) { g0[e] = __builtin_amdgcn_rcpf(1.f + __builtin_amdgcn_exp2f(-1.4426950408889634f * g0[e])); g1[e] = __builtin_amdgcn_rcpf(1.f + __builtin_amdgcn_exp2f(-1.4426950408889634f * g1[e])); }
                        const f32x4 o0 = (f32x4){bflo(hw.x), bfhi(hw.x), bflo(hw.y), bfhi(hw.y)} + g0 * p0;
                        const f32x4 o1 = (f32x4){bflo(hw.z), bfhi(hw.z), bflo(hw.w), bfhi(hw.w)} + g1 * p1;
                        if (fout) { *(f32x4*)(fout + off) = o0; *(f32x4*)(fout + off + 4) = o1; }
                        if (hb_out) *(u32x4*)(hb_out + off) = pack8(o0, o1);
                        sq += (o0[0] * o0[0] + o0[1] * o0[1]) + (o0[2] * o0[2] + o0[3] * o0[3]) + (o1[0] * o1[0] + o1[1] * o1[1]) + (o1[2] * o1[2] + o1[3] * o1[3]);
                    }
                    if (ssq_out) { sq += __shfl_xor(sq, 16); sq += __shfl_xor(sq, 32); if (fq == 0) atomicAdd(ssq_out + row, sq); }
                }
            }
    }
};

__device__ __forceinline__ void transpose_item(const float* W, int K, int N, bf16_t* WT, const float* gain, int mapmode, LAS float* scr, int item, int lane) {
    const int nblk = N / 64, kb = item / nblk, nb = item % nblk, k0 = 64 * kb, n0 = 64 * nb;
    const int lr = lane >> 4, lc = lane & 15;
    f32x4 v[16];
#pragma unroll
    for (int i = 0; i < 16; ++i) v[i] = __builtin_nontemporal_load((const f32x4*)(W + (size_t)(k0 + 4 * i + lr) * N + n0 + 4 * lc));
#pragma unroll
    for (int i = 0; i < 16; ++i) { const float gk = gain ? gain[k0 + 4 * i + lr] : 1.f; *(LAS f32x4*)(scr + (4 * i + lr) * 68 + 4 * lc) = v[i] * gk; }
    asm volatile("s_waitcnt lgkmcnt(0)" ::: "memory");
    const int c = lane & 7;
#pragma unroll
    for (int j = 0; j < 8; ++j) { const int n = (lane >> 3) + 8 * j; const LAS float* s = scr + (8 * c) * 68 + n;
        u32x4 o; o.x = pk2(s[0 * 68], s[1 * 68]); o.y = pk2(s[2 * 68], s[3 * 68]); o.z = pk2(s[4 * 68], s[5 * 68]); o.w = pk2(s[6 * 68], s[7 * 68]);
        int nn = n0 + n; if (mapmode == 1) { const int hh = nn >> 8, jj = nn & 255; nn = hh * 320 + (jj < 128 ? jj : jj + 64); }
        *(u32x4*)(WT + (size_t)nn * K + k0 + 8 * c) = o; }
    asm volatile("s_waitcnt lgkmcnt(0)" ::: "memory");
}

__device__ __forceinline__ void prologue(const Params& P, LAS unsigned char* lds, int wave) {
    const int lane = lane_id_asm();
    unsigned char* ws = P.ws;
    bf16_t* Wb = (bf16_t*)(ws + WS_W);
    LAS float* scr = (LAS float*)(lds + wave * 17408);
    const int G = gridDim.x, gw = blockIdx.x * NWAVES + wave, NGW = G * NWAVES;
    const int gt = blockIdx.x * NTHREADS + wave * 64 + lane, NGT = G * NTHREADS;
    constexpr int IT0 = 16 * 96, IT1 = 32 * 16, IT2 = 16 * 11, IT3 = 6 * 24, IT4 = 4 * 32, IT5 = 16 * 16, IT6 = 16 * 64, IT8 = 64 * 16, IT10 = 16 * 16, IT12 = 4 * 16;
    constexpr int NIT = IT0 + IT1 + IT2 + IT3 + IT4 + IT5 + 2 * IT6 + 2 * IT8 + 2 * IT10 + 2 * IT12;
#pragma unroll 1
    for (int it = gw; it < NIT; it += NGW) {
        int r = it; const float* W; int K, N, mapmode = 0; bf16_t* WT; const float* gain = nullptr;
        if (r < IT0) { W = P.in[3]; K = 1024; N = 6144; WT = Wb + W_RIN; gain = P.in[2]; }
        else if ((r -= IT0) < IT1) { W = P.in[5]; K = 2048; N = 1024; WT = Wb + W_ROUT; }
        else if ((r -= IT1) < IT2) { W = P.in[6]; K = 1024; N = 704; WT = Wb + W_MIN; gain = P.in[2] + 1024; }
        else if ((r -= IT2) < IT3) { W = P.in[9]; K = 384; N = 1536; WT = Wb + W_UQ; gain = P.in[7]; }
        else if ((r -= IT3) < IT4) { W = P.in[10]; K = 256; N = 2048; WT = Wb + W_UKV; gain = P.in[8]; mapmode = 1; }
        else if ((r -= IT4) < IT5) { W = P.in[13]; K = 1024; N = 1024; WT = Wb + W_MOUT; }
        else if ((r -= IT5) < 2 * IT6) { const int l = r >= IT6; r -= l * IT6; W = P.in[15] + (size_t)l * 1024 * 4096; K = 1024; N = 4096; WT = Wb + W_1 + (size_t)l * 4194304; gain = P.in[14] + l * 1024; }
        else if ((r -= 2 * IT6) < 2 * IT8) { const int l = r >= IT8; r -= l * IT8; W = P.in[16] + (size_t)l * 4096 * 1024; K = 4096; N = 1024; WT = Wb + W_2 + (size_t)l * 4194304; }
        else if ((r -= 2 * IT8) < 2 * IT10) { const int l = r >= IT10; r -= l * IT10; W = P.in[18] + (size_t)l * 1024 * 1024; K = 1024; N = 1024; WT = Wb + W_G + (size_t)l * 1048576; gain = P.in[17] + l * 1024; }
        else { r -= 2 * IT10; const int l = r >= IT12; r -= l * IT12; W = P.in[19] + (size_t)l * 256 * 1024; K = 256; N = 1024; WT = Wb + W_P + (size_t)l * 262144; }
        transpose_item(W, K, N, WT, gain, mapmode, scr, r, lane);
    }
    for (int i = gt; i < 64 * 1024 / 8; i += NGT) *(u32x4*)(Wb + W_MIN + (size_t)704 * 1024 + (size_t)i * 8) = (u32x4){0u, 0u, 0u, 0u};
    for (int i = gt; i < 8 * 64 * 256 / 8; i += NGT) { const int e = i * 8, hh = e / (64 * 256), r = (e / 256) % 64, c = e % 256;
        *(u32x4*)(Wb + W_UKV + (size_t)(hh * 320 + 128 + r) * 256 + c) = (u32x4){0u, 0u, 0u, 0u}; }
    { float* sq = (float*)(ws + WS_SSQ) + MT; for (int i = gt; i < 7 * MT / 4; i += NGT) *(f32x4*)(sq + (size_t)i * 4) = (f32x4){0.f, 0.f, 0.f, 0.f}; }
    { float* cR = (float*)(ws + WS_ROPE_R); float* sR = cR + 4096 * 128;
      for (int i = gt; i < 4096 * 128; i += NGT) { const int s = i >> 7, j = i & 127;
          const float inv = (float)exp2(-(double)j * (13.287712379549449 / 128.0)); const float ang = (float)s * inv;
          const double rev = (double)ang * 0.15915494309189535; const float fr = (float)(rev - rint(rev));
          cR[i] = __builtin_amdgcn_cosf(fr); sR[i] = __builtin_amdgcn_sinf(fr); }
      float* cM = (float*)(ws + WS_ROPE_M); float* sM = cM + 4096 * 32;
      for (int i = gt; i < 4096 * 32; i += NGT) { const int s = i >> 5, j = i & 31;
          const float inv = (float)exp2(-(double)j * (13.287712379549449 / 32.0)); const float ang = (float)s * inv;
          const double rev = (double)ang * 0.15915494309189535; const float fr = (float)(rev - rint(rev));
          cM[i] = __builtin_amdgcn_cosf(fr); sM[i] = __builtin_amdgcn_sinf(fr); } }
    { const float* x = P.in[0]; bf16_t* hb = (bf16_t*)(ws + WS_HBA); float* sq = (float*)(ws + WS_SSQ);
#pragma unroll 1
      for (int r = 2 * gw; r < MT; r += 2 * NGW) {
          const f32x4* xr = (const f32x4*)(x + (size_t)r * 1024) + lane; f32x4 v[8]; float s0 = 0.f, s1 = 0.f;
#pragma unroll
          for (int j = 0; j < 8; ++j) v[j] = __builtin_nontemporal_load(xr + 64 * j);
#pragma unroll
          for (int j = 0; j < 4; ++j) { s0 += (v[j][0] * v[j][0] + v[j][1] * v[j][1]) + (v[j][2] * v[j][2] + v[j][3] * v[j][3]);
              s1 += (v[4 + j][0] * v[4 + j][0] + v[4 + j][1] * v[4 + j][1]) + (v[4 + j][2] * v[4 + j][2] + v[4 + j][3] * v[4 + j][3]); }
          s0 = wave_sum(s0); s1 = wave_sum(s1); if (lane == 0) { sq[r] = s0; sq[r + 1] = s1; }
          u32x2* o = (u32x2*)(hb + (size_t)r * 1024) + lane;
#pragma unroll
          for (int j = 0; j < 8; ++j) { u32x2 w; w.x = pk2(v[j][0], v[j][1]); w.y = pk2(v[j][2], v[j][3]); o[64 * j] = w; }
      } }
    { float* sm = (float*)(ws + WS_SMALL); for (int i = gt; i < 2048 + 384; i += NGT) sm[i] = i < 2048 ? P.in[4][i] : (i < 2240 ? P.in[11][i - 2048] : P.in[12][i - 2240]); }
    { const f32x4* p4 = (const f32x4*)P.in[1]; u32x2* pb = (u32x2*)(ws + WS_PB);
#pragma unroll 1
      for (int i = gt; i < 2 * MT * 256 / 4; i += 4 * NGT) {
          f32x4 v[4];
#pragma unroll
          for (int j = 0; j < 4; ++j) v[j] = (i + j * NGT < 2 * MT * 256 / 4) ? __builtin_nontemporal_load(p4 + i + j * NGT) : (f32x4){0.f, 0.f, 0.f, 0.f};
#pragma unroll
          for (int j = 0; j < 4; ++j) if (i + j * NGT < 2 * MT * 256 / 4) { u32x2 w; w.x = pk2(v[j][0], v[j][1]); w.y = pk2(v[j][2], v[j][3]); pb[i + j * NGT] = w; }
      } }
}

struct FinRow { u32x4 kn0, kn1; u32x2 kr0, kr1; f32x4 c4, s4; };
__device__ __forceinline__ void fin_load(FinRow& R, const bf16_t* Q, const bf16_t* KV, const bf16_t* CQ, const float* cM, const float* sM, int r, int hh, int tt) {
    const bf16_t* kp = KV + (size_t)r * 2560 + hh * 320; const bf16_t* kr = CQ + (size_t)r * 768 + 640;
    const int s = r & (SEQ - 1);
    R.kn0 = *(const u32x4*)(kp + 16 * tt); R.kn1 = *(const u32x4*)(kp + 16 * tt + 8); R.kr0 = *(const u32x2*)(kr + 4 * tt); R.kr1 = *(const u32x2*)(kr + 32 + 4 * tt);
    R.c4 = *(const f32x4*)(cM + s * 32 + 4 * tt); R.s4 = *(const f32x4*)(sM + s * 32 + 4 * tt);
}
__device__ __forceinline__ void fin_one(bf16_t* dst, const u32x4 n0, const u32x4 n1, const u32x2 r0, const u32x2 r1, const f32x4 c4, const f32x4 s4, const float* gain, int tt, float scale) {
    float nv[16] = {bflo(n0.x), bfhi(n0.x), bflo(n0.y), bfhi(n0.y), bflo(n0.z), bfhi(n0.z), bflo(n0.w), bfhi(n0.w),
                    bflo(n1.x), bfhi(n1.x), bflo(n1.y), bfhi(n1.y), bflo(n1.z), bfhi(n1.z), bflo(n1.w), bfhi(n1.w)};
    float x1[4] = {bflo(r0.x), bfhi(r0.x), bflo(r0.y), bfhi(r0.y)}, x2[4] = {bflo(r1.x), bfhi(r1.x), bflo(r1.y), bfhi(r1.y)};
    float sq = 0.f;
#pragma unroll
    for (int j = 0; j < 16; ++j) sq += nv[j] * nv[j];
#pragma unroll
    for (int j = 0; j < 4; ++j) sq += x1[j] * x1[j] + x2[j] * x2[j];
    sq += __shfl_xor(sq, 1); sq += __shfl_xor(sq, 2); sq += __shfl_xor(sq, 4);
    const float rs = __builtin_amdgcn_rsqf(sq * (1.f / 192.f) + EPS) * scale;
#pragma unroll
    for (int j = 0; j < 16; ++j) nv[j] *= rs * gain[16 * tt + j];
    float o1[4], o2[4];
#pragma unroll
    for (int j = 0; j < 4; ++j) { const float a = x1[j] * rs * gain[128 + 4 * tt + j], bq = x2[j] * rs * gain[160 + 4 * tt + j]; o1[j] = a * c4[j] - bq * s4[j]; o2[j] = bq * c4[j] + a * s4[j]; }
    u32x4 w0, w1; w0.x = pk2(nv[0], nv[1]); w0.y = pk2(nv[2], nv[3]); w0.z = pk2(nv[4], nv[5]); w0.w = pk2(nv[6], nv[7]);
    w1.x = pk2(nv[8], nv[9]); w1.y = pk2(nv[10], nv[11]); w1.z = pk2(nv[12], nv[13]); w1.w = pk2(nv[14], nv[15]);
    *(u32x4*)(dst + 16 * tt) = w0; *(u32x4*)(dst + 16 * tt + 8) = w1;
    u32x2 v0, v1; v0.x = pk2(o1[0], o1[1]); v0.y = pk2(o1[2], o1[3]); v1.x = pk2(o2[0], o2[1]); v1.y = pk2(o2[2], o2[3]);
    *(u32x2*)(dst + 128 + 4 * tt) = v0; *(u32x2*)(dst + 160 + 4 * tt) = v1;
}
__device__ __forceinline__ void mla_finalize(const Params& P, int wave) {
    const int lane = lane_id_asm();
    unsigned char* ws = P.ws;
    bf16_t* Q = (bf16_t*)(ws + WS_R + R_Q); bf16_t* KV = (bf16_t*)(ws + WS_R + R_KV); const bf16_t* CQ = (const bf16_t*)(ws + WS_R + R_CQKV);
    const float* cM = (const float*)(ws + WS_ROPE_M); const float* sM = cM + 4096 * 32;
    const float* qg = (const float*)(ws + WS_SMALL) + 2048; const float* kg = qg + 192;
    const int hh = lane >> 3, tt = lane & 7;
    const float qscale = 0.07216878364870322f * 1.4426950408889634f;
    const int gw = blockIdx.x * NWAVES + wave, NGW = gridDim.x * NWAVES;
#pragma unroll 1
    for (int r = gw; r < MT; r += 2 * NGW) {
        const int r2 = r + NGW; const bool two = r2 < MT;
        FinRow A, B;
        fin_load(A, Q, KV, CQ, cM, sM, r, hh, tt);
        fin_load(B, Q, KV, CQ, cM, sM, two ? r2 : r, hh, tt);
        fin_one(KV + (size_t)r * 2560 + hh * 320, A.kn0, A.kn1, A.kr0, A.kr1, A.c4, A.s4, kg, tt, 1.f);
        if (two) {
            fin_one(KV + (size_t)r2 * 2560 + hh * 320, B.kn0, B.kn1, B.kr0, B.kr1, B.c4, B.s4, kg, tt, 1.f);
        }
    }
}

typedef float f32x16 __attribute__((ext_vector_type(16)));
typedef short v4i16_t __attribute__((ext_vector_type(4)));
__device__ __forceinline__ bf16x8 tr_pair(const LAS unsigned char* p0, const LAS unsigned char* p1) {
    const v4i16_t lo = __builtin_amdgcn_ds_read_tr16_b64_v4i16((LAS v4i16_t*)p0), hi = __builtin_amdgcn_ds_read_tr16_b64_v4i16((LAS v4i16_t*)p1);
    return (bf16x8){lo[0], lo[1], lo[2], lo[3], hi[0], hi[1], hi[2], hi[3]};
}
__device__ __forceinline__ bf16x8 pack8bf(float a0, float a1, float a2, float a3, float a4, float a5, float a6, float a7) {
    u32x4 w; w.x = cvt_pk_bf16(a0, a1); w.y = cvt_pk_bf16(a2, a3); w.z = cvt_pk_bf16(a4, a5); w.w = cvt_pk_bf16(a6, a7); return __builtin_bit_cast(bf16x8, w);
}
typedef short s16x4 __attribute__((ext_vector_type(4)));
#define TR_READ(dst, addr, off) asm volatile("ds_read_b64_tr_b16 %0, %1 offset:%c2" : "=v"(dst) : "v"(addr), "i"(off) : "memory")
#define TR_WAIT4(n, a, b, c, d) asm volatile("s_waitcnt lgkmcnt(" #n ")" : "+v"(a), "+v"(b), "+v"(c), "+v"(d) :: "memory")
__device__ __forceinline__ void att_qk_sm(const LAS unsigned char* kb, int klane, const bf16x8 (&qf)[12], f32x16 (&o)[4], float& mrun, float& lrun, bf16x8 (&pb)[4]) {
    constexpr int KP = 400;
    f32x16 s0, s1;
#pragma unroll
    for (int i = 0; i < 16; ++i) { s0[i] = 0.f; s1[i] = 0.f; }
    bf16x8 ka[3][2];
#pragma unroll
    for (int g = 0; g < 2; ++g) { ka[g][0] = *(const LAS bf16x8*)(kb + klane + g * 32); ka[g][1] = *(const LAS bf16x8*)(kb + klane + 32 * KP + g * 32); }
#pragma unroll
    for (int g = 0; g < 12; ++g) {
        if (g < 10) { ka[(g + 2) % 3][0] = *(const LAS bf16x8*)(kb + klane + (g + 2) * 32); ka[(g + 2) % 3][1] = *(const LAS bf16x8*)(kb + klane + 32 * KP + (g + 2) * 32); }
        __builtin_amdgcn_sched_barrier(0);
        s0 = __builtin_amdgcn_mfma_f32_32x32x16_bf16(ka[g % 3][0], qf[g], s0, 0, 0, 0);
        s1 = __builtin_amdgcn_mfma_f32_32x32x16_bf16(ka[g % 3][1], qf[g], s1, 0, 0, 0);
        __builtin_amdgcn_sched_barrier(0);
    }
    float mx = fmaxf(s0[0], s1[0]);
#pragma unroll
    for (int i = 1; i < 16; ++i) asm("v_max3_f32 %0, %1, %2, %3" : "=v"(mx) : "v"(mx), "v"(s0[i]), "v"(s1[i]));
    { const auto rr = __builtin_amdgcn_permlane32_swap(__float_as_uint(mx), __float_as_uint(mx), false, false);
      mx = fmaxf(__uint_as_float(rr[0]), __uint_as_float(rr[1])); }
    if (!__all(mx - mrun <= 8.0f)) {
        const float mn = fmaxf(mrun, mx), al = __builtin_amdgcn_exp2f(mrun - mn);
        mrun = mn; lrun *= al;
#pragma unroll
        for (int d = 0; d < 4; ++d) o[d] = o[d] * al;
    }
    float ps = 0.f;
#pragma unroll
    for (int i = 0; i < 16; ++i) { s0[i] = __builtin_amdgcn_exp2f(s0[i] - mrun); s1[i] = __builtin_amdgcn_exp2f(s1[i] - mrun); ps += s0[i] + s1[i]; }
    lrun += ps;
    pb[0] = pack8bf(s0[0], s0[1], s0[2], s0[3], s0[4], s0[5], s0[6], s0[7]);
    pb[1] = pack8bf(s0[8], s0[9], s0[10], s0[11], s0[12], s0[13], s0[14], s0[15]);
    pb[2] = pack8bf(s1[0], s1[1], s1[2], s1[3], s1[4], s1[5], s1[6], s1[7]);
    pb[3] = pack8bf(s1[8], s1[9], s1[10], s1[11], s1[12], s1[13], s1[14], s1[15]);
    __builtin_amdgcn_sched_barrier(0);
}
__device__ __forceinline__ void att_pv(const LAS unsigned char* kb, int vlane, const bf16x8 (&pb)[4], f32x16 (&o)[4]) {
    constexpr int VP = 320;
    s16x4 vlo[2][4], vhi[2][4];
    const unsigned vaddr = (unsigned)(unsigned long)(kb + vlane);
#pragma unroll
    for (int d = 0; d < 4; ++d) { TR_READ(vlo[0][d], vaddr, d * 64); TR_READ(vhi[0][d], vaddr, 8 * VP + d * 64); }
#pragma unroll
    for (int ks = 0; ks < 4; ++ks) {
        if (ks < 3) {
#pragma unroll
            for (int d = 0; d < 4; ++d) { TR_READ(vlo[(ks + 1) & 1][d], vaddr, ((ks + 1) * 16) * VP + d * 64); TR_READ(vhi[(ks + 1) & 1][d], vaddr, ((ks + 1) * 16 + 8) * VP + d * 64); }
            TR_WAIT4(8, vlo[ks & 1][0], vlo[ks & 1][1], vlo[ks & 1][2], vlo[ks & 1][3]); TR_WAIT4(8, vhi[ks & 1][0], vhi[ks & 1][1], vhi[ks & 1][2], vhi[ks & 1][3]);
        } else {
            TR_WAIT4(0, vlo[ks & 1][0], vlo[ks & 1][1], vlo[ks & 1][2], vlo[ks & 1][3]); TR_WAIT4(0, vhi[ks & 1][0], vhi[ks & 1][1], vhi[ks & 1][2], vhi[ks & 1][3]);
        }
        __builtin_amdgcn_sched_barrier(0);
#pragma unroll
        for (int d = 0; d < 4; ++d) { const bf16x8 a = __builtin_shufflevector(vlo[ks & 1][d], vhi[ks & 1][d], 0, 1, 2, 3, 4, 5, 6, 7);
            o[d] = __builtin_amdgcn_mfma_f32_32x32x16_bf16(a, pb[ks], o[d], 0, 0, 0); }
        __builtin_amdgcn_sched_barrier(0);
    }
}
__device__ __forceinline__ void att_mfma(const Params& P, LAS unsigned char* lds, int wave) {
    unsigned char* ws = P.ws;
    const bf16_t* Q = (const bf16_t*)(ws + WS_R + R_Q); const bf16_t* KV = (const bf16_t*)(ws + WS_R + R_KV); bf16_t* O = (bf16_t*)(ws + WS_R + R_O);
    const int lane = lane_id_asm(), q32 = lane & 31, hf = lane >> 5;
    constexpr int KP = 400, VP = 320, KB = 64 * KP, BUF = KB + 64 * VP;
    unsigned goff[6];
#pragma unroll
    for (int i = 0; i < 6; ++i) { int q = wave + 8 * i; q = q > 44 ? 44 : q; int p = q * 64 + lane;
        if (q < 25) { const int r = p / 25; int c = p % 25; c = c == 24 ? 0 : c; goff[i] = (unsigned)(r * 5120 + c * 16); }
        else { p -= 1600; const int r = p / 20; int c = p % 20; c = c >= 16 ? 0 : c; goff[i] = (unsigned)(r * 5120 + 384 + c * 16); } }
#define ATT_ISSUE(tilebase, bufbase) do { const unsigned char* _tb = (tilebase); asm volatile("" : "+s"(_tb)); _Pragma("unroll") for (int _i = 0; _i < 6; ++_i) { int _q = wave + 8 * _i; _q = _q > 44 ? 44 : _q; \
        __builtin_amdgcn_global_load_lds((const unsigned*)(_tb + goff[_i]), (LAS unsigned*)((bufbase) + _q * 1024), 16, 0, 0); } } while (0)
#define ATT_BAR() do { asm volatile("s_waitcnt vmcnt(0) lgkmcnt(0)" ::: "memory"); __builtin_amdgcn_s_barrier(); asm volatile("" ::: "memory"); } while (0)
    const int i16 = lane & 15, blk = (lane >> 4) & 1;
    const int vlane = KB + ((i16 >> 2) + 4 * hf) * VP + (16 * blk + 4 * (i16 & 3)) * 2;
    const int klane = q32 * KP + hf * 16;
    const bool roleA = wave < 4;
    const int w4 = wave & 3;
    for (int u = blockIdx.x; u < 1024; u += gridDim.x) {
        const int bh = u & 63, r = u >> 6, kk = r >> 2, j4 = r & 3;
        const int qb = kk == 0 ? j4 : (kk == 1 ? 15 - j4 : (kk == 2 ? 4 + j4 : 11 - j4));
        const int b = bh >> 3, hh = bh & 7;
        const int ntile = 4 * qb + 4, my_last = 4 * qb + w4;
        const size_t qrow_g = (size_t)b * SEQ + qb * 256 + w4 * 64 + (wave >> 2) * 32 + q32;
        const unsigned char* kvb = (const unsigned char*)(KV + (size_t)b * SEQ * 2560 + hh * 320);
        ATT_ISSUE(kvb, lds);
        bf16x8 qf[12];
        { const bf16_t* qp = Q + qrow_g * 1536 + hh * 192 + hf * 8;
#pragma unroll
          for (int ks = 0; ks < 12; ++ks) qf[ks] = *(const bf16x8*)(qp + ks * 16); }
        f32x16 o[4];
#pragma unroll
        for (int d = 0; d < 4; ++d)
#pragma unroll
            for (int i = 0; i < 16; ++i) o[d][i] = 0.f;
        float mrun = -1e30f, lrun = 0.f;
        bf16x8 pb[4];
#pragma unroll
        for (int i = 0; i < 4; ++i) pb[i] = (bf16x8){0, 0, 0, 0, 0, 0, 0, 0};
        ATT_BAR();
#pragma unroll
        for (int ks = 0; ks < 12; ++ks) asm volatile("" : "+v"(qf[ks]));
        {
            float qv[12][8]; float sq = 0.f;
#pragma unroll
            for (int ks = 0; ks < 12; ++ks)
#pragma unroll
                for (int e = 0; e < 8; ++e) { qv[ks][e] = bf2f((unsigned short)qf[ks][e]); sq += qv[ks][e] * qv[ks][e]; }
            { const auto rr = __builtin_amdgcn_permlane32_swap(__float_as_uint(sq), __float_as_uint(sq), false, false);
              sq = __uint_as_float(rr[0]) + __uint_as_float(rr[1]); }
            const float rs = __builtin_amdgcn_rsqf(sq * (1.f / 192.f) + EPS) * (0.07216878364870322f * 1.4426950408889634f);
            const float* qg = (const float*)(ws + WS_SMALL) + 2048 + 8 * hf;
            const int spos = (int)(qrow_g & (SEQ - 1));
            const float* cM = (const float*)(ws + WS_ROPE_M) + spos * 32 + 8 * hf; const float* sM = cM + 4096 * 32;
#pragma unroll
            for (int ks = 0; ks < 12; ++ks) { const f32x4 g0 = *(const f32x4*)(qg + 16 * ks), g1 = *(const f32x4*)(qg + 16 * ks + 4);
#pragma unroll
                for (int e = 0; e < 4; ++e) { qv[ks][e] *= rs * g0[e]; qv[ks][4 + e] *= rs * g1[e]; } }
#pragma unroll
            for (int k2 = 0; k2 < 2; ++k2) {
                const f32x4 c0 = *(const f32x4*)(cM + 16 * k2), c1 = *(const f32x4*)(cM + 16 * k2 + 4), s0 = *(const f32x4*)(sM + 16 * k2), s1 = *(const f32x4*)(sM + 16 * k2 + 4);
#pragma unroll
                for (int e = 0; e < 8; ++e) { const float cc = e < 4 ? c0[e & 3] : c1[e & 3], ss = e < 4 ? s0[e & 3] : s1[e & 3];
                    const float a = qv[8 + k2][e], bq = qv[10 + k2][e]; qv[8 + k2][e] = a * cc - bq * ss; qv[10 + k2][e] = bq * cc + a * ss; }
            }
#pragma unroll
            for (int ks = 0; ks < 12; ++ks) qf[ks] = pack8bf(qv[ks][0], qv[ks][1], qv[ks][2], qv[ks][3], qv[ks][4], qv[ks][5], qv[ks][6], qv[ks][7]);
        }
        int bcur = 0, bprev = 2, bnext = 1;
#pragma unroll 1
        for (int kt = 0; kt < ntile; ++kt) {
            if (kt + 1 < ntile) ATT_ISSUE(kvb + (size_t)(kt + 1) * 327680, lds + bnext * BUF);
            if (!roleA && kt >= 1 && kt - 1 <= my_last) att_pv(lds + bprev * BUF, vlane, pb, o);
            if (kt <= my_last) att_qk_sm(lds + bcur * BUF, klane, qf, o, mrun, lrun, pb);
            if (roleA && kt <= my_last) att_pv(lds + bcur * BUF, vlane, pb, o);
            ATT_BAR();
            bprev = bcur; bcur = bnext; bnext = bnext == 2 ? 0 : bnext + 1;
        }
        if (!roleA && ntile - 1 <= my_last) att_pv(lds + bprev * BUF, vlane, pb, o);
        ATT_BAR();
        const float lt = lrun + __shfl_xor(lrun, 32), il = 1.f / lt;
        bf16_t* op = O + qrow_g * 1024 + hh * 128 + 4 * hf;
#pragma unroll
        for (int d = 0; d < 4; ++d)
#pragma unroll
            for (int j = 0; j < 4; ++j) { u32x2 w; w.x = cvt_pk_bf16(o[d][4 * j] * il, o[d][4 * j + 1] * il); w.y = cvt_pk_bf16(o[d][4 * j + 2] * il, o[d][4 * j + 3] * il);
                *(u32x2*)(op + d * 32 + 8 * j) = w; }
    }
#undef ATT_ISSUE
#undef ATT_BAR
}

__device__ __forceinline__ void ret_mfma(const Params& P, LAS unsigned char* lds, int wave) {
    unsigned char* ws = P.ws;
    const bf16_t* QK = (const bf16_t*)(ws + WS_R + R_QK); bf16_t* V = (bf16_t*)(ws + WS_R + R_V); float* rssq = (float*)(ws + WS_RSSQ);
    constexpr int QP = 528, VP = 192, SP = 144;
    constexpr int Q_OFF = 0, K_OFF = 33792, V_OFF = 67584, VS_OFF = 79872, ST_OFF = 92160, S_OFF = 125952;
    const int lane = lane_id_asm(), t = wave * 64 + lane, q32 = lane & 31, hf = lane >> 5, i16 = lane & 15, blk = (lane >> 4) & 1;
    const int trrow = 8 * hf + (i16 >> 2), trcol = (16 * blk + 4 * (i16 & 3)) * 2;
    for (int unit = blockIdx.x; unit < 256; unit += gridDim.x) {
        const int xcd_ = unit & 7, idx_ = unit >> 3, bh = xcd_ * 4 + (idx_ >> 3), slice = idx_ & 7, b = bh >> 2, hh = bh & 3;
        const float gam = 1.f - exp2f(-5.f - (float)hh), lg = log2f(gam), g64 = exp2f(lg * 64.f);
        for (int i = t; i < 33792 / 16; i += NTHREADS) *(LAS u32x4*)(lds + ST_OFF + i * 16) = (u32x4){0u, 0u, 0u, 0u};
        f32x16 st[2];
#pragma unroll
        for (int a = 0; a < 2; ++a)
#pragma unroll
            for (int i = 0; i < 16; ++i) st[a][i] = 0.f;
        const size_t rb = (size_t)b * SEQ;
        float dec[16];
        { const int mblk = (wave & 3) >> 1, nblk = wave & 1, n = nblk * 32 + q32;
#pragma unroll
          for (int i = 0; i < 16; ++i) { const int mm = mblk * 32 + 8 * (i >> 2) + 4 * hf + (i & 3); const int dist = n > mm ? n - mm : mm - n;
              dec[i] = wave < 4 ? __builtin_amdgcn_exp2f(lg * (float)(dist - (63 - mm))) : __builtin_amdgcn_exp2f(lg * (float)(n + 1)); } }
        u32x4 pq[4], pkk[4], pvv;
        const int vr = t >> 3, vc = t & 7;
#pragma unroll
        for (int i = 0; i < 4; ++i) { const int id = t + 512 * i, r = id >> 5, ch = id & 31;
            pq[i] = *(const u32x4*)(QK + (rb + r) * 2048 + hh * 256 + ch * 8); pkk[i] = *(const u32x4*)(QK + (rb + r) * 2048 + 1024 + hh * 256 + ch * 8); }
        pvv = *(const u32x4*)(V + (rb + vr) * 2048 + hh * 512 + slice * 64 + vc * 8);
#pragma unroll 1
        for (int c = 0; c < 64; ++c) {
#pragma unroll
            for (int i = 0; i < 4; ++i) { const int id = t + 512 * i, r = id >> 5, ch = id & 31;
                *(LAS u32x4*)(lds + Q_OFF + r * QP + ch * 16) = pq[i]; *(LAS u32x4*)(lds + K_OFF + r * QP + ch * 16) = pkk[i]; }
            *(LAS u32x4*)(lds + V_OFF + vr * VP + vc * 16) = pvv;
            __syncthreads();
            if (c + 1 < 64) { const size_t r1 = rb + (size_t)(c + 1) * 64;
#pragma unroll
                for (int i = 0; i < 4; ++i) { const int id = t + 512 * i, r = id >> 5, ch = id & 31;
                    pq[i] = *(const u32x4*)(QK + (r1 + r) * 2048 + hh * 256 + ch * 8); pkk[i] = *(const u32x4*)(QK + (r1 + r) * 2048 + 1024 + hh * 256 + ch * 8); }
                pvv = *(const u32x4*)(V + (r1 + vr) * 2048 + hh * 512 + slice * 64 + vc * 8); }
            const size_t r0 = rb + (size_t)c * 64;
            f32x16 acc;
#pragma unroll
            for (int i = 0; i < 16; ++i) acc[i] = 0.f;
            if (wave < 4) {
                const int mblk = wave >> 1, nblk = wave & 1, n = nblk * 32 + q32;
#pragma unroll 4
                for (int ks = 0; ks < 16; ++ks) {
                    const bf16x8 a = *(const LAS bf16x8*)(lds + K_OFF + (mblk * 32 + q32) * QP + ks * 32 + hf * 16);
                    const bf16x8 bq = *(const LAS bf16x8*)(lds + Q_OFF + n * QP + ks * 32 + hf * 16);
                    acc = __builtin_amdgcn_mfma_f32_32x32x16_bf16(a, bq, acc, 0, 0, 0);
                }
#pragma unroll
                for (int i = 0; i < 16; ++i) acc[i] *= dec[i];
#pragma unroll
                for (int j = 0; j < 4; ++j) { u32x2 w; w.x = cvt_pk_bf16(acc[4 * j], acc[4 * j + 1]); w.y = cvt_pk_bf16(acc[4 * j + 2], acc[4 * j + 3]);
                    *(LAS u32x2*)(lds + S_OFF + n * SP + (mblk * 32 + 8 * j + 4 * hf) * 2) = w; }
            } else {
                const int w4 = wave - 4, dvblk = w4 >> 1, nblk = w4 & 1, n = nblk * 32 + q32;
#pragma unroll 4
                for (int ks = 0; ks < 16; ++ks) {
                    const bf16x8 a = *(const LAS bf16x8*)(lds + ST_OFF + (dvblk * 32 + q32) * QP + ks * 32 + hf * 16);
                    const bf16x8 bq = *(const LAS bf16x8*)(lds + Q_OFF + n * QP + ks * 32 + hf * 16);
                    acc = __builtin_amdgcn_mfma_f32_32x32x16_bf16(a, bq, acc, 0, 0, 0);
                }
                acc = acc * dec[0];
            }
            __syncthreads();
            {
#pragma unroll
                for (int a = 0; a < 2; ++a) st[a] = st[a] * g64;
#pragma unroll
                for (int ks = 0; ks < 4; ++ks) {
                    bf16x8 av[2], bk;
#pragma unroll
                    for (int vb = 0; vb < 2; ++vb) { const LAS unsigned char* p = lds + V_OFF + (16 * ks + trrow) * VP + vb * 64 + trcol; av[vb] = tr_pair(p, p + 4 * VP); }
                    { const LAS unsigned char* p = lds + K_OFF + (16 * ks + trrow) * QP + wave * 64 + trcol; bk = tr_pair(p, p + 4 * QP); }
#pragma unroll
                    for (int vb = 0; vb < 2; ++vb) st[vb] = __builtin_amdgcn_mfma_f32_32x32x16_bf16(av[vb], bk, st[vb], 0, 0, 0);
                }
#pragma unroll
                for (int vb = 0; vb < 2; ++vb)
#pragma unroll
                    for (int i = 0; i < 16; ++i) { const int dv = vb * 32 + 8 * (i >> 2) + 4 * hf + (i & 3);
                        *(LAS bf16_t*)(lds + ST_OFF + dv * QP + (wave * 32 + q32) * 2) = (bf16_t)(cvt_pk_bf16(st[vb][i], 0.f) & 0xffffu); }
            }
            if (wave >= 4) {
                const int w4 = wave - 4, dvblk = w4 >> 1, nblk = w4 & 1, n = nblk * 32 + q32;
#pragma unroll
                for (int ks = 0; ks < 4; ++ks) {
                    const LAS unsigned char* p = lds + V_OFF + (16 * ks + trrow) * VP + dvblk * 64 + trcol;
                    const bf16x8 a = tr_pair(p, p + 4 * VP);
                    const bf16x8 bs = *(const LAS bf16x8*)(lds + S_OFF + n * SP + (16 * ks + 8 * hf) * 2);
                    acc = __builtin_amdgcn_mfma_f32_32x32x16_bf16(a, bs, acc, 0, 0, 0);
                }
                float sq = 0.f;
#pragma unroll
                for (int i = 0; i < 16; ++i) sq += acc[i] * acc[i];
                sq += __shfl_xor(sq, 32);
                if (hf == 0) rssq[(r0 + n) * 64 + hh * 16 + slice * 2 + dvblk] = sq;
                bf16_t* op = V + (r0 + n) * 2048 + hh * 512 + slice * 64 + dvblk * 32 + 4 * hf;
#pragma unroll
                for (int j = 0; j < 4; ++j) { u32x2 w; w.x = cvt_pk_bf16(acc[4 * j], acc[4 * j + 1]); w.y = cvt_pk_bf16(acc[4 * j + 2], acc[4 * j + 3]); *(u32x2*)(op + 8 * j) = w; }
            }
            __syncthreads();
        }
    }
}

#define XB_TMO      128
#define XB_XCNT(j)  (256  + 64 * (j))
#define XB_XSUB(j)  (1280 + 64 * (j))
#define XB_XGEN(j)  (2304 + 64 * (j))
#define XB_TOP      3328
#define XB_TOPGEN   3392
#define XCD_BAR_WORDS 3456
#define XB_SPIN_CAP (1u << 18)

__device__ __forceinline__ unsigned xb_ld(unsigned* p)              { return __hip_atomic_load(p, __ATOMIC_RELAXED, __HIP_MEMORY_SCOPE_AGENT); }
__device__ __forceinline__ unsigned xb_add(unsigned* p, unsigned v) { return __hip_atomic_fetch_add(p, v, __ATOMIC_RELAXED, __HIP_MEMORY_SCOPE_AGENT); }
__device__ __forceinline__ unsigned xb_xcc_id() { return (unsigned)__builtin_amdgcn_s_getreg((3 << 11) | 20) & 0xFu; }
#define XB_SPIN(cond, bar) do { unsigned _sp = 0; while (cond) { __builtin_amdgcn_s_sleep(1); \
    if ((++_sp & 255u) == 0u) { if (xb_ld(&(bar)[XB_TMO])) break; if (_sp > XB_SPIN_CAP) { atomicAdd(&(bar)[XB_TMO], 1u); break; } } } } while (0)

struct XcdBarrier {
    unsigned* bar; unsigned x;
    volatile LAS unsigned* st;
};

__device__ __forceinline__ XcdBarrier xcd_barrier_post(unsigned* bar, volatile LAS unsigned* st) {
    XcdBarrier b; b.bar = bar; b.x = xb_xcc_id(); b.st = st;
    if (threadIdx.x == 0) (void)xb_add(&bar[XB_XCNT(b.x)], 1u);
    return b;
}
__device__ __forceinline__ void xcd_barrier_complete(unsigned* bar, unsigned x, unsigned& nloc, unsigned& nx) {
    const unsigned G = gridDim.x * gridDim.y * gridDim.z;
    unsigned sum, cnt, mine, sp = 0u;
    for (;;) {
        sum = 0u; cnt = 0u; mine = 0u;
#pragma unroll
        for (unsigned j = 0; j < 16; ++j) { const unsigned c = xb_ld(&bar[XB_XCNT(j)]); sum += c; cnt += (c > 0u) ? 1u : 0u; mine = (j == x) ? c : mine; }
        if (sum == G) break;
        __builtin_amdgcn_s_sleep(1);
        if ((++sp & 255u) == 0u) { if (xb_ld(&bar[XB_TMO])) break; if (sp > XB_SPIN_CAP) { atomicAdd(&bar[XB_TMO], 1u); break; } }
    }
    nloc = mine > 0u ? mine : 1u; nx = cnt > 0u ? cnt : 1u;
}

__device__ __forceinline__ void xcd_barrier(const XcdBarrier& b) {
    asm volatile("s_waitcnt vmcnt(0)" ::: "memory");
    __syncthreads();
    if (threadIdx.x == 0) {
        unsigned* bar = b.bar;
        __builtin_amdgcn_s_waitcnt(0);
        unsigned nloc = b.st[0], nx = b.st[1];
        if (nloc == 0u) { xcd_barrier_complete(bar, b.x, nloc, nx); b.st[0] = nloc; b.st[1] = nx; }
        const unsigned old = xb_add(&bar[XB_XSUB(b.x)], 1u);
        const unsigned gen = old / nloc;
        if (old + 1u == (gen + 1u) * nloc) {
            __builtin_amdgcn_fence(__ATOMIC_RELEASE, "agent");
            asm volatile("s_waitcnt vmcnt(0)" ::: "memory");
            const unsigned og = xb_add(&bar[XB_TOP], 1u);
            const unsigned tg = og / nx;
            if (og + 1u == (tg + 1u) * nx) xb_add(&bar[XB_TOPGEN], 1u);
            else XB_SPIN(xb_ld(&bar[XB_TOPGEN]) == tg, bar);
            __builtin_amdgcn_fence(__ATOMIC_ACQUIRE, "agent");
            xb_add(&bar[XB_XGEN(b.x)], 1u);
            asm volatile("s_waitcnt vmcnt(0)" ::: "memory");
        } else {
            XB_SPIN(xb_ld(&bar[XB_XGEN(b.x)]) == gen, bar);
            __builtin_amdgcn_fence(__ATOMIC_ACQUIRE, "agent");
            asm volatile("s_waitcnt vmcnt(0)" ::: "memory");
        }
    }
    __syncthreads();
}

#ifndef PHMASK
#define PHMASK 0xFFFFFF
#endif
#define PH(n) if constexpr (((PHMASK) >> (n)) & 1)
#ifndef DUPMASK
#define DUPMASK 0
#endif
#define DUP(n) for (int rep_ = 0; rep_ < 1 + (((DUPMASK) >> (n)) & 1); ++rep_)
__global__ void __launch_bounds__(NTHREADS, 2) fwd_megakernel(Params P) {
    extern __shared__ __attribute__((aligned(16))) unsigned char lds_raw[];
    LAS unsigned char* lds = (LAS unsigned char*)lds_raw;
    cg::grid_group grid = cg::this_grid();
    const int wave = __builtin_amdgcn_readfirstlane(threadIdx.x >> 6);
    unsigned char* ws = P.ws;
    const int G = gridDim.x, c = blockIdx.x;
    bf16_t* Wb = (bf16_t*)(ws + WS_W);
    float* SSQ = (float*)(ws + WS_SSQ);
    bf16_t* hbA = (bf16_t*)(ws + WS_HBA);
    bf16_t* hbB = (bf16_t*)P.out;
    unsigned char* R = ws + WS_R;
    float* h = P.out;

    { volatile LAS unsigned* stw = (volatile LAS unsigned*)(lds + LDS_BYTES - 64); if (threadIdx.x < 2) stw[threadIdx.x] = 0u; __syncthreads(); }
    const XcdBarrier xbar = xcd_barrier_post((unsigned*)(ws + WS_BAR), (volatile LAS unsigned*)(lds + LDS_BYTES - 64));
    PH(0) prologue(P, lds, wave);
    if (P.out == nullptr) grid.sync();
    xcd_barrier(xbar);

    {
    PH(1) { pg8::Gemm g{hbA, Wb + W_RIN, MT, 4096, 1024, 1024}; pg8::StaticOrder S; S.init(MT, 4096, G, c);
      EpiRope E{(bf16_t*)(R + R_QK), (bf16_t*)(R + R_V), SSQ + SQ_MIX0 * MT, (const float*)(ws + WS_ROPE_R), (const float*)(ws + WS_ROPE_R) + 4096 * 128};
      pg8::gemm_phase(lds, g, S, E, wave); }
    xcd_barrier(xbar);
    PH(2) ret_mfma(P, lds, wave);
    xcd_barrier(xbar);
    }
    PH(3) { pg8::Gemm g{hbA, Wb + W_RIN + (size_t)4096 * 1024, MT, 2048, 1024, 1024}; pg8::StaticOrder S; S.init(MT, 2048, G, c);
      EpiGateY E{(bf16_t*)(R + R_V), SSQ + SQ_MIX0 * MT, (const float*)(ws + WS_RSSQ), (const float*)(ws + WS_SMALL)};
      pg8::gemm_phase(lds, g, S, E, wave); }
    xcd_barrier(xbar);
    PH(4) { pg8::Gemm g{(const bf16_t*)(R + R_V), Wb + W_ROUT, MT, 1024, 2048, 2048}; pg8::StaticOrder S; S.init(MT, 1024, G, c, true);
      EpiResidual E{hbA, hbA, SSQ + SQ_MLP0 * MT, nullptr};
      pg8::gemm_phase(lds, g, S, E, wave); }
    xcd_barrier(xbar);

    PH(11) { { pg8::Gemm g{hbA, Wb + W_1 + (size_t)0 * 4194304, MT, 4096, 1024, 1024}; pg8::StaticOrder S; S.init(MT, 4096, G, c);
      EpiScale<1, false> E{(bf16_t*)(R + R_HID), 4096, nullptr, 0.f, nullptr, nullptr};
      pg8::gemm_phase(lds, g, S, E, wave); } }
    xcd_barrier(xbar);
    PH(12) { pg8::Gemm g{(const bf16_t*)(R + R_HID), Wb + W_2 + (size_t)0 * 4194304, MT, 1024, 4096, 4096}; pg8::StaticOrder S; S.init(MT, 1024, G, c, true);
      EpiResidual E{hbA, hbA, SSQ + SQ_PLE0 * MT, SSQ + SQ_MLP0 * MT};
      pg8::gemm_phase(lds, g, S, E, wave); }
    xcd_barrier(xbar);
    PH(13) { pg8::Gemm g{(const bf16_t*)(ws + WS_PB) + (size_t)0 * MT * 256, Wb + W_P + (size_t)0 * 262144, MT, 1024, 256, 256}; pg8::StaticOrder S; S.init(MT, 1024, G, c);
      EpiPlainNP E{(bf16_t*)(R + R_PP)};
      pg8::gemm_phase(lds, g, S, E, wave); }
    PH(14) { pg8::Gemm g{hbA, Wb + W_G + (size_t)0 * 1048576, MT, 1024, 1024, 1024}; pg8::StaticOrder S; S.init(MT, 1024, G, c);
      EpiPle E{hbA, (const bf16_t*)(R + R_PP), SSQ + SQ_PLE0 * MT, hbB, SSQ + SQ_MIX1 * MT, nullptr};
      pg8::gemm_phase(lds, g, S, E, wave); }
    xcd_barrier(xbar);
    PH(5) { pg8::Gemm g{hbB, Wb + W_MIN, MT, 768, 1024, 1024}; pg8::StaticOrder S; S.init(MT, 768, G, c);
      EpiScale<0, true> E{(bf16_t*)(R + R_CQKV), 768, SSQ + SQ_MIX1 * MT, 1.f / 1024.f, SSQ + SQ_CQ * MT, SSQ + SQ_CKV * MT};
      pg8::gemm_phase(lds, g, S, E, wave); }
    xcd_barrier(xbar);
    PH(6) { pg8::Gemm g{(const bf16_t*)(R + R_CQKV), Wb + W_UQ, MT, 1536, 384, 768}; pg8::StaticOrder S; S.init(MT, 1536, G, c);
      EpiScale<0, false> E{(bf16_t*)(R + R_Q), 1536, nullptr, 0.f, nullptr, nullptr};
      pg8::gemm_phase(lds, g, S, E, wave); }
    PH(7) { pg8::Gemm g{(const bf16_t*)(R + R_CQKV) + 384, Wb + W_UKV, MT, 2560, 256, 768}; pg8::StaticOrder S; S.init(MT, 2560, G, c);
      EpiScale<0, false> E{(bf16_t*)(R + R_KV), 2560, SSQ + SQ_CKV * MT, 1.f / 256.f, nullptr, nullptr};
      pg8::gemm_phase(lds, g, S, E, wave); }
    xcd_barrier(xbar);
    PH(8) mla_finalize(P, wave);
    xcd_barrier(xbar);
    PH(9) att_mfma(P, lds, wave);
    xcd_barrier(xbar);
    PH(10) { pg8::Gemm g{(const bf16_t*)(R + R_O), Wb + W_MOUT, MT, 1024, 1024, 1024}; pg8::StaticOrder S; S.init(MT, 1024, G, c);
      EpiResidual E{hbB, hbA, SSQ + SQ_MLP1 * MT, nullptr};
      pg8::gemm_phase(lds, g, S, E, wave); }
    xcd_barrier(xbar);
    PH(11) { pg8::Gemm g{hbA, Wb + W_1 + (size_t)1 * 4194304, MT, 4096, 1024, 1024}; pg8::StaticOrder S; S.init(MT, 4096, G, c);
      EpiScale<1, false> E{(bf16_t*)(R + R_HID), 4096, nullptr, 0.f, nullptr, nullptr};
      pg8::gemm_phase(lds, g, S, E, wave); }
    xcd_barrier(xbar);
    PH(12) { pg8::Gemm g{(const bf16_t*)(R + R_HID), Wb + W_2 + (size_t)1 * 4194304, MT, 1024, 4096, 4096}; pg8::StaticOrder S; S.init(MT, 1024, G, c, true);
      EpiResidual E{hbA, hbA, SSQ + SQ_PLE1 * MT, SSQ + SQ_MLP1 * MT};
      pg8::gemm_phase(lds, g, S, E, wave); }
    xcd_barrier(xbar);
    PH(13) { pg8::Gemm g{(const bf16_t*)(ws + WS_PB) + (size_t)1 * MT * 256, Wb + W_P + (size_t)1 * 262144, MT, 1024, 256, 256}; pg8::StaticOrder S; S.init(MT, 1024, G, c);
      EpiPlainNP E{(bf16_t*)(R + R_PP)};
      pg8::gemm_phase(lds, g, S, E, wave); }
    PH(14) { pg8::Gemm g{hbA, Wb + W_G + (size_t)1 * 1048576, MT, 1024, 1024, 1024}; pg8::StaticOrder S; S.init(MT, 1024, G, c);
      EpiPle E{hbA, (const bf16_t*)(R + R_PP), SSQ + SQ_PLE1 * MT, nullptr, nullptr, h};
      pg8::gemm_phase(lds, g, S, E, wave); }
#ifdef SYNCPROBE
    for (int i_ = 0; i_ < 8; ++i_) xcd_barrier(xbar);
#endif
}

extern "C" void kernel_launch(void* const* d_in, const int* in_sizes, int n_in, void* d_out, int out_size, void* d_ws, size_t ws_size, hipStream_t stream) {
    static int grid_blocks = 0;
    if (grid_blocks == 0) {
        if (n_in != 20 || out_size != MT * DM || ws_size < WS_END) { fprintf(stderr, "kernel_launch: unexpected shapes (n_in %d out %d ws %zu)\n", n_in, out_size, ws_size); grid_blocks = -1; return; }
        int dev = 0, cus = 0, per_cu = 0;
        hipGetDevice(&dev);
        hipDeviceGetAttribute(&cus, hipDeviceAttributeMultiprocessorCount, dev);
        if (hipFuncSetAttribute((const void*)fwd_megakernel, hipFuncAttributeMaxDynamicSharedMemorySize, LDS_BYTES) != hipSuccess) { fprintf(stderr, "kernel_launch: hipFuncSetAttribute failed\n"); grid_blocks = -1; return; }
        hipOccupancyMaxActiveBlocksPerMultiprocessor(&per_cu, (const void*)fwd_megakernel, NTHREADS, LDS_BYTES);
        if (per_cu < 1) { fprintf(stderr, "kernel_launch: occupancy query says %d blocks per CU\n", per_cu); grid_blocks = -1; return; }
        grid_blocks = cus * per_cu;
    }
    if (grid_blocks < 0) return;
    if (hipMemsetAsync((char*)d_ws + WS_BAR, 0, 16384, stream) != hipSuccess) { fprintf(stderr, "kernel_launch: memset failed\n"); return; }
    Params p{};
    for (int i = 0; i < 20; ++i) p.in[i] = (const float*)d_in[i];
    p.out = (float*)d_out; p.ws = (unsigned char*)d_ws;
    void* args[] = {&p};
    hipError_t e = hipLaunchCooperativeKernel((const void*)fwd_megakernel, dim3(grid_blocks), dim3(NTHREADS), args, LDS_BYTES, stream);
    if (e != hipSuccess) fprintf(stderr, "cooperative launch failed: %s (grid %d)\n", hipGetErrorString(e), grid_blocks);
}
```

```cpp
#include <hip/hip_runtime.h>
#include <hip/hip_cooperative_groups.h>
#include <cstdio>
#include <cstdint>
namespace cg = cooperative_groups;

#define LAS __attribute__((address_space(3)))
typedef unsigned short bf16_t;
typedef short bf16x8 __attribute__((ext_vector_type(8)));
typedef float f32x4 __attribute__((ext_vector_type(4)));
typedef float f32x2 __attribute__((ext_vector_type(2)));
typedef unsigned u32x4 __attribute__((ext_vector_type(4)));
typedef unsigned u32x2 __attribute__((ext_vector_type(2)));


constexpr int MT = 32768, SEQ = 4096, DM = 1024, FF = 4096, PLE = 256;
constexpr float EPS = 1e-6f;
constexpr int NTHREADS = 512, NWAVES = 8;
constexpr int LDS_BYTES = 160 * 1024;

constexpr size_t MiB = 1u << 20;
constexpr size_t WS_SSQ = 0;
constexpr size_t WS_RSSQ = 496 * MiB;
constexpr size_t WS_ROPE_R = 5 * MiB;
constexpr size_t WS_ROPE_M = 9 * MiB;
constexpr size_t WS_SMALL = 10 * MiB;
constexpr size_t WS_BAR = 12 * MiB;
constexpr size_t WS_W = 16 * MiB;
constexpr size_t WS_PB = 80 * MiB;
constexpr size_t WS_HBA = 112 * MiB;
constexpr size_t WS_R = 176 * MiB;
constexpr size_t WS_END = 512 * MiB;
constexpr size_t R_QK = 0;
constexpr size_t R_V = 128 * MiB;
constexpr size_t R_HID = 0;
constexpr size_t R_PP = 160 * MiB;
constexpr size_t R_HBB = 64 * MiB;
constexpr size_t R_CQKV = 0;
constexpr size_t R_O = 0;
constexpr size_t R_Q = 64 * MiB;
constexpr size_t R_KV = 160 * MiB;
constexpr size_t W_RIN = 0, W_ROUT = 6291456, W_MIN = 8388608, W_UQ = 9175040, W_UKV = 9764864, W_MOUT = 10420224,
                 W_1 = 11468800, W_2 = 19857408, W_G = 28246016, W_P = 30343168;
enum { SQ_MIX0 = 0, SQ_MLP0, SQ_PLE0, SQ_MIX1, SQ_MLP1, SQ_PLE1, SQ_CQ, SQ_CKV };

struct Params {
    const float* in[20];
    float* out;
    unsigned char* ws;
};

__device__ __forceinline__ unsigned f2bf(float f) { unsigned u = __builtin_bit_cast(unsigned, f); return (u + 0x7fffu + ((u >> 16) & 1u)) >> 16; }
typedef __bf16 bf16x2_t __attribute__((ext_vector_type(2)));
__device__ __forceinline__ unsigned cvt_pk_bf16(float lo, float hi) { f32x2 v = {lo, hi}; bf16x2_t b = __builtin_convertvector(v, bf16x2_t); return __builtin_bit_cast(unsigned, b); }
__device__ __forceinline__ unsigned pk2(float lo, float hi) { return cvt_pk_bf16(lo, hi); }
__device__ __forceinline__ float bf2f(unsigned short b) { return __builtin_bit_cast(float, (unsigned)b << 16); }
__device__ __forceinline__ float bflo(unsigned w) { return __builtin_bit_cast(float, w << 16); }
__device__ __forceinline__ float bfhi(unsigned w) { return __builtin_bit_cast(float, w & 0xffff0000u); }
__device__ __forceinline__ int lane_id_asm() { int l; asm volatile("v_mbcnt_lo_u32_b32 %0, -1, 0\n\tv_mbcnt_hi_u32_b32 %0, -1, %0" : "=v"(l)); return l; }
__device__ __forceinline__ float wave_sum(float v) {
#pragma unroll
    for (int o = 1; o < 64; o <<= 1) v += __shfl_xor(v, o);
    return v;
}
__device__ __forceinline__ float wave_max(float v) {
#pragma unroll
    for (int o = 1; o < 64; o <<= 1) v = fmaxf(v, __shfl_xor(v, o));
    return v;
}

namespace pg8 {
constexpr int BM = 256, BK = 64, HALF = 128, HTB = HALF * BK * 2, STAGE_BYTES = 8 * HTB, NXCD = 8, WGM = 4;
__device__ __forceinline__ int lds_byte(int r, int c) { const int st = (r >> 4) * 2 + (c >> 5), rr = r & 15, cc = c & 31, ob = rr * 64 + cc * 2; return st * 1024 + (ob ^ (((ob >> 9) & 1) << 5)); }
__device__ __forceinline__ void stage_rc(int b, int& R, int& C) { const int st = b / 1024, sb = b % 1024, swz = sb ^ (((sb >> 9) & 1) << 5); R = (st >> 1) * 16 + swz / 64; C = (st & 1) * 32 + (swz % 64) / 2; }
__device__ __forceinline__ int perm32(int rho) { const int n = rho >> 4, i = rho & 15; return 8 * (i >> 2) + 4 * n + (i & 3); }

struct Unit { int pm, pn; };
struct Gemm { const bf16_t* A; const bf16_t* Bt; int M, N, K, lda; };

struct StaticOrder {
    int nM, nN, nwg, G, c; bool rev;
    __device__ void init(int M, int N, int G_, int c_, bool rev_ = false) { nM = M / BM; nN = N / BM; nwg = nM * nN; G = G_; c = c_; rev = rev_; }
    __device__ bool next(int i, Unit& u) const {
        long L = (long)i * G + c; if (L >= nwg) return false;
        if (rev) L = nwg - 1 - L;
        int wgid = (int)L; { const int q = nwg / NXCD, r = nwg % NXCD, xcd = wgid % NXCD, off = wgid / NXCD; wgid = (xcd < r ? xcd * (q + 1) : r * (q + 1) + (xcd - r) * q) + off; }
        const int nig = WGM * nN, gid = wgid / nig, fm = gid * WGM, gsz = (nM - fm) < WGM ? (nM - fm) : WGM;
        u.pm = fm + ((wgid % nig) % gsz); u.pn = (wgid % nig) / gsz; return true;
    }
};

template <class Epi>
__device__ __forceinline__ void gemm_phase(LAS unsigned char* lds, const Gemm g, const StaticOrder& S, const Epi& E, const int wid) {
    const int lane = lane_id_asm(), tid = wid * 64 + lane, wr = wid >> 2, wc = wid & 3, fr = lane & 15, fq = lane >> 4;
    const int K = g.K, nt = K / BK, lda = g.lda;
    unsigned voffA[2], voffB[2];
#pragma unroll
    for (int i = 0; i < 2; ++i) { int R, C; stage_rc(tid * 16 + i * 8192, R, C); const int Rb = Epi::PERM ? ((R & ~31) + perm32(R & 31)) : R;
        voffA[i] = (unsigned)(R * lda + C) * 2u; voffB[i] = (unsigned)(Rb * K + C) * 2u; }
    const size_t kstep = (size_t)(BK * 2);
    const size_t hsA = (size_t)HALF * lda * 2, hsB = (size_t)HALF * K * 2;
    const size_t tsA = 2 * hsA, tsB = 2 * hsB;
    const unsigned ldsw = (unsigned)wid * 1024u;
    const int aoff = lds_byte(wr * 64 + fr, fq * 8), boff = lds_byte(wc * 32 + fr, fq * 8);
#define PG8_SA(b, h) (((b) * 2 + (h)) * HTB)
#define PG8_SB(b, h) ((4 + (b) * 2 + (h)) * HTB)
#define PG8_STAGE(bufoff, gbase, voff) do { _Pragma("unroll") for (int _i = 0; _i < 2; ++_i) \
        __builtin_amdgcn_global_load_lds((const unsigned*)((const char*)(gbase) + (voff)[_i]), (LAS unsigned*)(lds + (bufoff) + ldsw + _i * 8192), 16, 0, 0); } while (0)
#define PG8_LDA(dst, b, h) do { _Pragma("unroll") for (int m = 0; m < 4; ++m) _Pragma("unroll") for (int k = 0; k < 2; ++k) dst[m][k] = *(const LAS bf16x8*)(lds + PG8_SA(b, h) + aoff + m * 2048 + k * 1024); } while (0)
#define PG8_LDB(dst, b, h) do { _Pragma("unroll") for (int n = 0; n < 2; ++n) _Pragma("unroll") for (int k = 0; k < 2; ++k) dst[n][k] = *(const LAS bf16x8*)(lds + PG8_SB(b, h) + boff + n * 2048 + k * 1024); } while (0)
#define PG8_MMA(ai, bj, At, Bt) do { __builtin_amdgcn_s_setprio(1); _Pragma("unroll") for (int m = 0; m < 4; ++m) _Pragma("unroll") for (int n = 0; n < 2; ++n) _Pragma("unroll") for (int k = 0; k < 2; ++k) \
        acc[ai][bj][m][n] = __builtin_amdgcn_mfma_f32_16x16x32_bf16(Bt[n][k], At[m][k], acc[ai][bj][m][n], 0, 0, 0); __builtin_amdgcn_s_setprio(0); } while (0)
#define PG8_WAIT_V(n) asm volatile("s_waitcnt vmcnt(" #n ")" ::: "memory")
#define PG8_WAIT_L(n) asm volatile("s_waitcnt lgkmcnt(" #n ")" ::: "memory")
#define PG8_BAR __builtin_amdgcn_s_barrier()
#define PG8_SCHED __builtin_amdgcn_sched_barrier(0)
    Unit cur, nxt; int ui = 0;
    if (!S.next(0, cur)) return;
    f32x4 acc[2][2][4][2];
#pragma unroll
    for (int a = 0; a < 2; ++a)
#pragma unroll
        for (int b = 0; b < 2; ++b)
#pragma unroll
            for (int m = 0; m < 4; ++m)
#pragma unroll
                for (int n = 0; n < 2; ++n) acc[a][b][m][n] = (f32x4){0.f, 0.f, 0.f, 0.f};
    bf16x8 At[4][2], B0[2][2], B1[2][2];
    const char* cA = (const char*)g.A + (size_t)cur.pm * tsA; const char* cB = (const char*)g.Bt + (size_t)cur.pn * tsB;
    PG8_STAGE(PG8_SB(0, 0), cB, voffB); PG8_STAGE(PG8_SB(0, 1), cB + hsB, voffB); PG8_STAGE(PG8_SA(0, 0), cA, voffA); PG8_STAGE(PG8_SA(0, 1), cA + hsA, voffA);
    if (wr == 1) PG8_BAR;
    PG8_WAIT_V(2); PG8_BAR;
    PG8_STAGE(PG8_SB(1, 0), cB + kstep, voffB); PG8_STAGE(PG8_SA(1, 0), cA + kstep, voffA); PG8_STAGE(PG8_SB(1, 1), cB + hsB + kstep, voffB);
    PG8_WAIT_V(6); PG8_BAR;
    for (;;) {
        const bool has_next = S.next(ui + 1, nxt);
        const char* nA = has_next ? (const char*)g.A + (size_t)nxt.pm * tsA : cA; const char* nB = has_next ? (const char*)g.Bt + (size_t)nxt.pn * tsB : cB;
#pragma unroll 1
        for (int t = 0; t < nt; t += 2) {
            const bool last = (t == nt - 2);
            const char* a1 = cA + (size_t)(t + 1) * kstep;
            const char* a2 = last ? nA : cA + (size_t)(t + 2) * kstep; const char* b2 = last ? nB : cB + (size_t)(t + 2) * kstep;
            const char* a3 = a2 + kstep; const char* b3 = b2 + kstep;
            PG8_LDB(B0, 0, 0); PG8_LDB(B1, 0, 1); PG8_SCHED; PG8_LDA(At, 0, 0); PG8_STAGE(PG8_SA(1, 1), a1 + hsA, voffA);
            PG8_WAIT_V(8); PG8_WAIT_L(0); PG8_BAR; PG8_MMA(0, 0, At, B0); PG8_MMA(0, 1, At, B1); PG8_BAR; PG8_SCHED;
            PG8_LDA(At, 0, 1); PG8_STAGE(PG8_SB(0, 0), b2, voffB); PG8_STAGE(PG8_SB(0, 1), b2 + hsB, voffB); PG8_STAGE(PG8_SA(0, 0), a2, voffA);
            PG8_WAIT_V(8); PG8_WAIT_L(0); PG8_BAR; PG8_MMA(1, 0, At, B0); PG8_MMA(1, 1, At, B1); PG8_BAR; PG8_SCHED;
            PG8_LDB(B0, 1, 0); PG8_LDB(B1, 1, 1); PG8_SCHED; PG8_LDA(At, 1, 0); PG8_STAGE(PG8_SA(0, 1), a2 + hsA, voffA);
            PG8_WAIT_V(8); PG8_WAIT_L(0); PG8_BAR; PG8_MMA(0, 0, At, B0); PG8_MMA(0, 1, At, B1); PG8_BAR; PG8_SCHED;
            PG8_LDA(At, 1, 1); PG8_STAGE(PG8_SB(1, 0), b3, voffB); PG8_STAGE(PG8_SB(1, 1), b3 + hsB, voffB); PG8_STAGE(PG8_SA(1, 0), a3, voffA);
            PG8_WAIT_V(8); PG8_WAIT_L(0); PG8_BAR; PG8_MMA(1, 0, At, B0); PG8_MMA(1, 1, At, B1); PG8_BAR; PG8_SCHED;
        }
        if (wr == 0) PG8_BAR;
        E(acc, cur, wid);
        if (!has_next) break;
#pragma unroll
        for (int a = 0; a < 2; ++a)
#pragma unroll
            for (int b = 0; b < 2; ++b)
#pragma unroll
                for (int m = 0; m < 4; ++m)
#pragma unroll
                    for (int n = 0; n < 2; ++n) acc[a][b][m][n] = (f32x4){0.f, 0.f, 0.f, 0.f};
        cur = nxt; cA = nA; cB = nB; ++ui;
        if (wr == 1) PG8_BAR;
    }
    PG8_WAIT_V(0);
    PG8_BAR;
#undef PG8_SA
#undef PG8_SB
#undef PG8_STAGE
#undef PG8_LDA
#undef PG8_LDB
#undef PG8_MMA
#undef PG8_WAIT_V
#undef PG8_WAIT_L
#undef PG8_BAR
#undef PG8_SCHED
}
}

typedef f32x4 Acc[2][2][4][2];
__device__ __forceinline__ float rstd_of(const float* ssq, int row, float inv_n) { return __builtin_amdgcn_rsqf(ssq[row] * inv_n + EPS); }
__device__ __forceinline__ u32x4 pack8(f32x4 a, f32x4 b) { u32x4 w; w.x = pk2(a[0], a[1]); w.y = pk2(a[2], a[3]); w.z = pk2(b[0], b[1]); w.w = pk2(b[2], b[3]); return w; }

template <int ACT  , bool SSQP>
struct EpiScale {
    static constexpr bool PERM = true;
    bf16_t* O; int ldc; const float* ssq; float inv_n; float* ssqA; float* ssqB;
    __device__ __forceinline__ void operator()(const Acc& acc, const pg8::Unit& u, int wid) const {
        const int lane_ = lane_id_asm(), wr = wid >> 2, wc = wid & 3, fr = lane_ & 15, fq = lane_ >> 4;
        const int row0 = u.pm * 256 + wr * 64 + fr, col0 = u.pn * 256 + wc * 32 + 8 * fq;
        float scv[8];
#pragma unroll
        for (int i = 0; i < 8; ++i) scv[i] = ssq ? ssq[row0 + (i >> 2) * 128 + (i & 3) * 16] : 0.f;
#pragma unroll
        for (int ai = 0; ai < 2; ++ai)
#pragma unroll
            for (int m = 0; m < 4; ++m) {
                const int row = row0 + ai * 128 + m * 16;
                const float sc = ssq ? __builtin_amdgcn_rsqf(scv[ai * 4 + m] * inv_n + EPS) : 1.f;
#pragma unroll
                for (int bj = 0; bj < 2; ++bj) {
                    f32x4 v0 = acc[ai][bj][m][0] * sc, v1 = acc[ai][bj][m][1] * sc;
                    if (ACT == 1) {
#pragma unroll
                        for (int e = 0; e < 4; ++e) { float a = fmaxf(v0[e], 0.f), b = fmaxf(v1[e], 0.f); v0[e] = a * a; v1[e] = b * b; }
                    }
                    *(u32x4*)(O + (size_t)row * ldc + col0 + bj * 128) = pack8(v0, v1);
                    if (SSQP) {
                        float s = 0.f;
#pragma unroll
                        for (int e = 0; e < 4; ++e) s += v0[e] * v0[e] + v1[e] * v1[e];
                        s += __shfl_xor(s, 16); s += __shfl_xor(s, 32);
                        const int hidx = 2 * u.pn + bj;
                        if (fq == 0 && hidx < 5) atomicAdd((hidx < 3 ? ssqA : ssqB) + row, s);
                    }
                }
            }
    }
};

struct EpiRope {
    static constexpr bool PERM = true;
    bf16_t* QK; bf16_t* V; const float* ssq; const float* cosT; const float* sinT;
    __device__ __forceinline__ void operator()(const Acc& acc, const pg8::Unit& u, int wid) const {
        const int lane_ = lane_id_asm(), wr = wid >> 2, wc = wid & 3, fr = lane_ & 15, fq = lane_ >> 4;
        const int row0 = u.pm * 256 + wr * 64 + fr, colL = wc * 32 + 8 * fq, pn = u.pn;
        float scv[8];
#pragma unroll
        for (int i = 0; i < 8; ++i) scv[i] = ssq[row0 + (i >> 2) * 128 + (i & 3) * 16];
        if (pn < 8) {
            const float kmul = pn >= 4 ? 0.0625f : 1.f;
#pragma unroll
            for (int ai = 0; ai < 2; ++ai)
#pragma unroll
                for (int mp = 0; mp < 2; ++mp) {
                    f32x4 c4[2][2], s4[2][2];
#pragma unroll
                    for (int mm = 0; mm < 2; ++mm) { const int s = (row0 + ai * 128 + (2 * mp + mm) * 16) & (SEQ - 1);
#pragma unroll
                        for (int n = 0; n < 2; ++n) { c4[mm][n] = *(const f32x4*)(cosT + (size_t)s * 128 + colL + 4 * n); s4[mm][n] = *(const f32x4*)(sinT + (size_t)s * 128 + colL + 4 * n); } }
#pragma unroll
                    for (int mm = 0; mm < 2; ++mm) { const int m = 2 * mp + mm, row = row0 + ai * 128 + m * 16;
                        const float ks = __builtin_amdgcn_rsqf(scv[ai * 4 + m] * (1.f / 1024.f) + EPS) * kmul;
                        f32x4 o1[2], o2[2];
#pragma unroll
                        for (int n = 0; n < 2; ++n) { const f32x4 x1 = acc[ai][0][m][n] * ks, x2 = acc[ai][1][m][n] * ks;
                            o1[n] = x1 * c4[mm][n] - x2 * s4[mm][n]; o2[n] = x2 * c4[mm][n] + x1 * s4[mm][n]; }
                        bf16_t* p = QK + (size_t)row * 2048 + pn * 256 + colL;
                        *(u32x4*)p = pack8(o1[0], o1[1]); *(u32x4*)(p + 128) = pack8(o2[0], o2[1]); }
                }
        } else {
            const float lgh = __builtin_amdgcn_logf(1.f - __builtin_amdgcn_exp2f(-5.f - (float)((pn - 8) >> 1)));
#pragma unroll
            for (int ai = 0; ai < 2; ++ai)
#pragma unroll
                for (int m = 0; m < 4; ++m) { const int row = row0 + ai * 128 + m * 16;
                    const float sc = __builtin_amdgcn_rsqf(scv[ai * 4 + m] * (1.f / 1024.f) + EPS) * __builtin_amdgcn_exp2f(lgh * (float)(63 - (row & 63)));
                    bf16_t* p = V + (size_t)row * 2048 + (pn - 8) * 256 + colL;
#pragma unroll
                    for (int bj = 0; bj < 2; ++bj) *(u32x4*)(p + bj * 128) = pack8(acc[ai][bj][m][0] * sc, acc[ai][bj][m][1] * sc); }
        }
    }
};

struct EpiGateY {
    static constexpr bool PERM = true;
    bf16_t* Y; const float* ssq; const float* rssq; const float* gn;
    __device__ __forceinline__ void operator()(const Acc& acc, const pg8::Unit& u, int wid) const {
        const int lane_ = lane_id_asm(), wr = wid >> 2, wc = wid & 3, fr = lane_ & 15, fq = lane_ >> 4;
        const int row0 = u.pm * 256 + wr * 64 + fr, col0 = u.pn * 256 + wc * 32 + 8 * fq, head = u.pn >> 1;
        f32x4 g4[2][2];
#pragma unroll
        for (int bj = 0; bj < 2; ++bj) { g4[bj][0] = *(const f32x4*)(gn + col0 + bj * 128); g4[bj][1] = *(const f32x4*)(gn + col0 + bj * 128 + 4); }
#pragma unroll
        for (int ai = 0; ai < 2; ++ai)
#pragma unroll
            for (int mp = 0; mp < 2; ++mp) {
                float scv[2]; f32x4 rq[2][4]; u32x4 ov[2][2];
#pragma unroll
                for (int mm = 0; mm < 2; ++mm) { const int row = row0 + ai * 128 + (2 * mp + mm) * 16;
                    scv[mm] = ssq[row];
                    const f32x4* rp = (const f32x4*)(rssq + (size_t)row * 64 + head * 16);
#pragma unroll
                    for (int i = 0; i < 4; ++i) rq[mm][i] = rp[i];
#pragma unroll
                    for (int bj = 0; bj < 2; ++bj) ov[mm][bj] = *(const u32x4*)(Y + (size_t)row * 2048 + col0 + bj * 128); }
#pragma unroll
                for (int mm = 0; mm < 2; ++mm) { const int m = 2 * mp + mm, row = row0 + ai * 128 + m * 16;
                    const float sc = __builtin_amdgcn_rsqf(scv[mm] * (1.f / 1024.f) + EPS);
                    const f32x4 pa = (rq[mm][0] + rq[mm][1]) + (rq[mm][2] + rq[mm][3]);
                    const float rg = __builtin_amdgcn_rsqf(((pa[0] + pa[1]) + (pa[2] + pa[3])) * (1.f / 512.f) + EPS);
#pragma unroll
                    for (int bj = 0; bj < 2; ++bj) {
                        const u32x4 w = ov[mm][bj];
                        f32x4 o0 = (f32x4){bflo(w.x), bfhi(w.x), bflo(w.y), bfhi(w.y)}, o1 = (f32x4){bflo(w.z), bfhi(w.z), bflo(w.w), bfhi(w.w)};
                        f32x4 a0 = acc[ai][bj][m][0] * sc, a1 = acc[ai][bj][m][1] * sc;
#pragma unroll
                        for (int e = 0; e < 4; ++e) { a0[e] = a0[e] * __builtin_amdgcn_rcpf(1.f + __builtin_amdgcn_exp2f(-1.4426950408889634f * a0[e])); a1[e] = a1[e] * __builtin_amdgcn_rcpf(1.f + __builtin_amdgcn_exp2f(-1.4426950408889634f * a1[e])); }
                        o0 = a0 * o0 * g4[bj][0] * rg; o1 = a1 * o1 * g4[bj][1] * rg;
                        *(u32x4*)(Y + (size_t)row * 2048 + col0 + bj * 128) = pack8(o0, o1);
                    } }
            }
    }
};

struct EpiResidual {
    static constexpr bool PERM = true;
    const bf16_t* base; bf16_t* hb; float* ssq_out; const float* ssq2;
    __device__ __forceinline__ void operator()(const Acc& acc, const pg8::Unit& u, int wid) const {
        const int lane_ = lane_id_asm(), wr = wid >> 2, wc = wid & 3, fr = lane_ & 15, fq = lane_ >> 4;
        const int row0 = u.pm * 256 + wr * 64 + fr, col0 = u.pn * 256 + wc * 32 + 8 * fq;
        float r2[8];
#pragma unroll
        for (int i = 0; i < 8; ++i) r2[i] = ssq2 ? ssq2[row0 + (i >> 2) * 128 + (i & 3) * 16] : 0.f;
        u32x4 bv[2][4][2];
#pragma unroll
        for (int ai = 0; ai < 2; ++ai)
#pragma unroll
            for (int m = 0; m < 4; ++m)
#pragma unroll
                for (int bj = 0; bj < 2; ++bj) bv[ai][m][bj] = *(const u32x4*)(base + (size_t)(row0 + ai * 128 + m * 16) * 1024 + col0 + bj * 128);
#pragma unroll
        for (int ai = 0; ai < 2; ++ai) {
#pragma unroll
            for (int m = 0; m < 4; ++m) {
                const int row = row0 + ai * 128 + m * 16; float sq = 0.f;
                const float rr = ssq2 ? __builtin_amdgcn_rcpf(r2[ai * 4 + m] * (1.f / 1024.f) + EPS) : 1.f;
#pragma unroll
                for (int bj = 0; bj < 2; ++bj) {
                    const u32x4 b4 = bv[ai][m][bj];
                    const f32x4 o0 = (f32x4){bflo(b4.x), bfhi(b4.x), bflo(b4.y), bfhi(b4.y)} + acc[ai][bj][m][0] * rr;
                    const f32x4 o1 = (f32x4){bflo(b4.z), bfhi(b4.z), bflo(b4.w), bfhi(b4.w)} + acc[ai][bj][m][1] * rr;
                    *(u32x4*)(hb + (size_t)row * 1024 + col0 + bj * 128) = pack8(o0, o1);
                    sq += (o0[0] * o0[0] + o0[1] * o0[1]) + (o0[2] * o0[2] + o0[3] * o0[3]) + (o1[0] * o1[0] + o1[1] * o1[1]) + (o1[2] * o1[2] + o1[3] * o1[3]);
                }
                if (ssq_out) { sq += __shfl_xor(sq, 16); sq += __shfl_xor(sq, 32); if (fq == 0) atomicAdd(ssq_out + row, sq); }
            }
        }
    }
};

struct EpiPlainNP {
    static constexpr bool PERM = true;
    bf16_t* O;
    __device__ __forceinline__ void operator()(const Acc& acc, const pg8::Unit& u, int wid) const {
        const int lane_ = lane_id_asm(), wr = wid >> 2, wc = wid & 3, fr = lane_ & 15, fq = lane_ >> 4;
        const int row0 = u.pm * 256 + wr * 64 + fr, col0 = u.pn * 256 + wc * 32 + 8 * fq;
#pragma unroll
        for (int ai = 0; ai < 2; ++ai)
#pragma unroll
            for (int m = 0; m < 4; ++m)
#pragma unroll
                for (int bj = 0; bj < 2; ++bj) *(u32x4*)(O + (size_t)(row0 + ai * 128 + m * 16) * 1024 + col0 + bj * 128) = pack8(acc[ai][bj][m][0], acc[ai][bj][m][1]);
    }
};

struct EpiPle {
    static constexpr bool PERM = true;
    const bf16_t* hbase; const bf16_t* pp; const float* ssq; bf16_t* hb_out; float* ssq_out; float* fout;
    __device__ __forceinline__ void operator()(const Acc& acc, const pg8::Unit& u, int wid) const {
        const int lane_ = lane_id_asm(), wr = wid >> 2, wc = wid & 3, fr = lane_ & 15, fq = lane_ >> 4;
        const int row0 = u.pm * 256 + wr * 64 + fr, col0 = u.pn * 256 + wc * 32 + 8 * fq;
#pragma unroll
        for (int ai = 0; ai < 2; ++ai)
#pragma unroll
            for (int mp = 0; mp < 2; ++mp) {
                u32x4 hv[2][2], pw[2][2]; float scv[2];
#pragma unroll
                for (int mm = 0; mm < 2; ++mm) {
                    const int row = row0 + ai * 128 + (2 * mp + mm) * 16;
                    scv[mm] = ssq[row];
#pragma unroll
                    for (int bj = 0; bj < 2; ++bj) { const size_t off = (size_t)row * 1024 + col0 + bj * 128; hv[mm][bj] = *(const u32x4*)(hbase + off); pw[mm][bj] = *(const u32x4*)(pp + off); }
                }
#pragma unroll
                for (int mm = 0; mm < 2; ++mm) {
                    const int m = 2 * mp + mm, row = row0 + ai * 128 + m * 16; float sq = 0.f;
                    const float sc = __builtin_amdgcn_rsqf(scv[mm] * (1.f / 1024.f) + EPS);
#pragma unroll
                    for (int bj = 0; bj < 2; ++bj) {
                        const size_t off = (size_t)row * 1024 + col0 + bj * 128;
                        const u32x4 pwv = pw[mm][bj], hw = hv[mm][bj];
                        const f32x4 p0 = (f32x4){bflo(pwv.x), bfhi(pwv.x), bflo(pwv.y), bfhi(pwv.y)}, p1 = (f32x4){bflo(pwv.z), bfhi(pwv.z), bflo(pwv.w), bfhi(pwv.w)};
                        f32x4 g0 = acc[ai][bj][m][0] * sc, g1 = acc[ai][bj][m][1] * sc;
#pragma unroll
                        for (int e = 0; e < 4; ++e) { g0[e] = __builtin_amdgcn_rcpf(1.f + __builtin_amdgcn_exp2f(-1.4426950408889634f * g0[e])); g1[e] = __builtin_amdgcn_rcpf(1.f + __builtin_amdgcn_exp2f(-1.4426950408889634f * g1[e])); }
                        const f32x4 o0 = (f32x4){bflo(hw.x), bfhi(hw.x), bflo(hw.y), bfhi(hw.y)} + g0 * p0;
                        const f32x4 o1 = (f32x4){bflo(hw.z), bfhi(hw.z), bflo(hw.w), bfhi(hw.w)} + g1 * p1;
                        if (fout) { *(f32x4*)(fout + off) = o0; *(f32x4*)(fout + off + 4) = o1; }
                        if (hb_out) *(u32x4*)(hb_out + off) = pack8(o0, o1);
                        sq += (o0[0] * o0[0] + o0[1] * o0[1]) + (o0[2] * o0[2] + o0[3] * o0[3]) + (o1[0] * o1[0] + o1[1] * o1[1]) + (o1[2] * o1[2] + o1[3] * o1[3]);
                    }
                    if (ssq_out) { sq += __shfl_xor(sq, 16); sq += __shfl_xor(sq, 32); if (fq == 0) atomicAdd(ssq_out + row, sq); }
                }
            }
    }
};

__device__ __forceinline__ void transpose_item(const float* W, int K, int N, bf16_t* WT, const float* gain, int mapmode, LAS float* scr, int item, int lane) {
    const int nblk = N / 64, kb = item / nblk, nb = item % nblk, k0 = 64 * kb, n0 = 64 * nb;
    const int lr = lane >> 4, lc = lane & 15;
    f32x4 v[16];
#pragma unroll
    for (int i = 0; i < 16; ++i) v[i] = __builtin_nontemporal_load((const f32x4*)(W + (size_t)(k0 + 4 * i + lr) * N + n0 + 4 * lc));
#pragma unroll
    for (int i = 0; i < 16; ++i) { const float gk = gain ? gain[k0 + 4 * i + lr] : 1.f; *(LAS f32x4*)(scr + (4 * i + lr) * 68 + 4 * lc) = v[i] * gk; }
    asm volatile("s_waitcnt lgkmcnt(0)" ::: "memory");
    const int c = lane & 7;
#pragma unroll
    for (int j = 0; j < 8; ++j) { const int n = (lane >> 3) + 8 * j; const LAS float* s = scr + (8 * c) * 68 + n;
        u32x4 o; o.x = pk2(s[0 * 68], s[1 * 68]); o.y = pk2(s[2 * 68], s[3 * 68]); o.z = pk2(s[4 * 68], s[5 * 68]); o.w = pk2(s[6 * 68], s[7 * 68]);
        int nn = n0 + n; if (mapmode == 1) { const int hh = nn >> 8, jj = nn & 255; nn = hh * 320 + (jj < 128 ? jj : jj + 64); }
        *(u32x4*)(WT + (size_t)nn * K + k0 + 8 * c) = o; }
    asm volatile("s_waitcnt lgkmcnt(0)" ::: "memory");
}

__device__ __forceinline__ void prologue(const Params& P, LAS unsigned char* lds, int wave) {
    const int lane = lane_id_asm();
    unsigned char* ws = P.ws;
    bf16_t* Wb = (bf16_t*)(ws + WS_W);
    LAS float* scr = (LAS float*)(lds + wave * 17408);
    const int G = gridDim.x, gw = blockIdx.x * NWAVES + wave, NGW = G * NWAVES;
    const int gt = blockIdx.x * NTHREADS + wave * 64 + lane, NGT = G * NTHREADS;
    constexpr int IT0 = 16 * 96, IT1 = 32 * 16, IT2 = 16 * 11, IT3 = 6 * 24, IT4 = 4 * 32, IT5 = 16 * 16, IT6 = 16 * 64, IT8 = 64 * 16, IT10 = 16 * 16, IT12 = 4 * 16;
    constexpr int NIT = IT0 + IT1 + IT2 + IT3 + IT4 + IT5 + 2 * IT6 + 2 * IT8 + 2 * IT10 + 2 * IT12;
#pragma unroll 1
    for (int it = gw; it < NIT; it += NGW) {
        int r = it; const float* W; int K, N, mapmode = 0; bf16_t* WT; const float* gain = nullptr;
        if (r < IT0) { W = P.in[3]; K = 1024; N = 6144; WT = Wb + W_RIN; gain = P.in[2]; }
        else if ((r -= IT0) < IT1) { W = P.in[5]; K = 2048; N = 1024; WT = Wb + W_ROUT; }
        else if ((r -= IT1) < IT2) { W = P.in[6]; K = 1024; N = 704; WT = Wb + W_MIN; gain = P.in[2] + 1024; }
        else if ((r -= IT2) < IT3) { W = P.in[9]; K = 384; N = 1536; WT = Wb + W_UQ; gain = P.in[7]; }
        else if ((r -= IT3) < IT4) { W = P.in[10]; K = 256; N = 2048; WT = Wb + W_UKV; gain = P.in[8]; mapmode = 1; }
        else if ((r -= IT4) < IT5) { W = P.in[13]; K = 1024; N = 1024; WT = Wb + W_MOUT; }
        else if ((r -= IT5) < 2 * IT6) { const int l = r >= IT6; r -= l * IT6; W = P.in[15] + (size_t)l * 1024 * 4096; K = 1024; N = 4096; WT = Wb + W_1 + (size_t)l * 4194304; gain = P.in[14] + l * 1024; }
        else if ((r -= 2 * IT6) < 2 * IT8) { const int l = r >= IT8; r -= l * IT8; W = P.in[16] + (size_t)l * 4096 * 1024; K = 4096; N = 1024; WT = Wb + W_2 + (size_t)l * 4194304; }
        else if ((r -= 2 * IT8) < 2 * IT10) { const int l = r >= IT10; r -= l * IT10; W = P.in[18] + (size_t)l * 1024 * 1024; K = 1024; N = 1024; WT = Wb + W_G + (size_t)l * 1048576; gain = P.in[17] + l * 1024; }
        else { r -= 2 * IT10; const int l = r >= IT12; r -= l * IT12; W = P.in[19] + (size_t)l * 256 * 1024; K = 256; N = 1024; WT = Wb + W_P + (size_t)l * 262144; }
        transpose_item(W, K, N, WT, gain, mapmode, scr, r, lane);
    }
    for (int i = gt; i < 64 * 1024 / 8; i += NGT) *(u32x4*)(Wb + W_MIN + (size_t)704 * 1024 + (size_t)i * 8) = (u32x4){0u, 0u, 0u, 0u};
    for (int i = gt; i < 8 * 64 * 256 / 8; i += NGT) { const int e = i * 8, hh = e / (64 * 256), r = (e / 256) % 64, c = e % 256;
        *(u32x4*)(Wb + W_UKV + (size_t)(hh * 320 + 128 + r) * 256 + c) = (u32x4){0u, 0u, 0u, 0u}; }
    { float* sq = (float*)(ws + WS_SSQ) + MT; for (int i = gt; i < 7 * MT / 4; i += NGT) *(f32x4*)(sq + (size_t)i * 4) = (f32x4){0.f, 0.f, 0.f, 0.f}; }
    { float* cR = (float*)(ws + WS_ROPE_R); float* sR = cR + 4096 * 128;
      for (int i = gt; i < 4096 * 128; i += NGT) { const int s = i >> 7, j = i & 127;
          const float inv = (float)exp2(-(double)j * (13.287712379549449 / 128.0)); const float ang = (float)s * inv;
          const double rev = (double)ang * 0.15915494309189535; const float fr = (float)(rev - rint(rev));
          cR[i] = __builtin_amdgcn_cosf(fr); sR[i] = __builtin_amdgcn_sinf(fr); }
      float* cM = (float*)(ws + WS_ROPE_M); float* sM = cM + 4096 * 32;
      for (int i = gt; i < 4096 * 32; i += NGT) { const int s = i >> 5, j = i & 31;
          const float inv = (float)exp2(-(double)j * (13.287712379549449 / 32.0)); const float ang = (float)s * inv;
          const double rev = (double)ang * 0.15915494309189535; const float fr = (float)(rev - rint(rev));
          cM[i] = __builtin_amdgcn_cosf(fr); sM[i] = __builtin_amdgcn_sinf(fr); } }
    { const float* x = P.in[0]; bf16_t* hb = (bf16_t*)(ws + WS_HBA); float* sq = (float*)(ws + WS_SSQ);
#pragma unroll 1
      for (int r = 2 * gw; r < MT; r += 2 * NGW) {
          const f32x4* xr = (const f32x4*)(x + (size_t)r * 1024) + lane; f32x4 v[8]; float s0 = 0.f, s1 = 0.f;
#pragma unroll
          for (int j = 0; j < 8; ++j) v[j] = __builtin_nontemporal_load(xr + 64 * j);
#pragma unroll
          for (int j = 0; j < 4; ++j) { s0 += (v[j][0] * v[j][0] + v[j][1] * v[j][1]) + (v[j][2] * v[j][2] + v[j][3] * v[j][3]);
              s1 += (v[4 + j][0] * v[4 + j][0] + v[4 + j][1] * v[4 + j][1]) + (v[4 + j][2] * v[4 + j][2] + v[4 + j][3] * v[4 + j][3]); }
          s0 = wave_sum(s0); s1 = wave_sum(s1); if (lane == 0) { sq[r] = s0; sq[r + 1] = s1; }
          u32x2* o = (u32x2*)(hb + (size_t)r * 1024) + lane;
#pragma unroll
          for (int j = 0; j < 8; ++j) { u32x2 w; w.x = pk2(v[j][0], v[j][1]); w.y = pk2(v[j][2], v[j][3]); o[64 * j] = w; }
      } }
    { float* sm = (float*)(ws + WS_SMALL); for (int i = gt; i < 2048 + 384; i += NGT) sm[i] = i < 2048 ? P.in[4][i] : (i < 2240 ? P.in[11][i - 2048] : P.in[12][i - 2240]); }
    { const f32x4* p4 = (const f32x4*)P.in[1]; u32x2* pb = (u32x2*)(ws + WS_PB);
#pragma unroll 1
      for (int i = gt; i < 2 * MT * 256 / 4; i += 4 * NGT) {
          f32x4 v[4];
#pragma unroll
          for (int j = 0; j < 4; ++j) v[j] = (i + j * NGT < 2 * MT * 256 / 4) ? __builtin_nontemporal_load(p4 + i + j * NGT) : (f32x4){0.f, 0.f, 0.f, 0.f};
#pragma unroll
          for (int j = 0; j < 4; ++j) if (i + j * NGT < 2 * MT * 256 / 4) { u32x2 w; w.x = pk2(v[j][0], v[j][1]); w.y = pk2(v[j][2], v[j][3]); pb[i + j * NGT] = w; }
      } }
}

struct FinRow { u32x4 kn0, kn1; u32x2 kr0, kr1; f32x4 c4, s4; };
__device__ __forceinline__ void fin_load(FinRow& R, const bf16_t* Q, const bf16_t* KV, const bf16_t* CQ, const float* cM, const float* sM, int r, int hh, int tt) {
    const bf16_t* kp = KV + (size_t)r * 2560 + hh * 320; const bf16_t* kr = CQ + (size_t)r * 768 + 640;
    const int s = r & (SEQ - 1);
    R.kn0 = *(const u32x4*)(kp + 16 * tt); R.kn1 = *(const u32x4*)(kp + 16 * tt + 8); R.kr0 = *(const u32x2*)(kr + 4 * tt); R.kr1 = *(const u32x2*)(kr + 32 + 4 * tt);
    R.c4 = *(const f32x4*)(cM + s * 32 + 4 * tt); R.s4 = *(const f32x4*)(sM + s * 32 + 4 * tt);
}
__device__ __forceinline__ void fin_one(bf16_t* dst, const u32x4 n0, const u32x4 n1, const u32x2 r0, const u32x2 r1, const f32x4 c4, const f32x4 s4, const float* gain, int tt, float scale) {
    float nv[16] = {bflo(n0.x), bfhi(n0.x), bflo(n0.y), bfhi(n0.y), bflo(n0.z), bfhi(n0.z), bflo(n0.w), bfhi(n0.w),
                    bflo(n1.x), bfhi(n1.x), bflo(n1.y), bfhi(n1.y), bflo(n1.z), bfhi(n1.z), bflo(n1.w), bfhi(n1.w)};
    float x1[4] = {bflo(r0.x), bfhi(r0.x), bflo(r0.y), bfhi(r0.y)}, x2[4] = {bflo(r1.x), bfhi(r1.x), bflo(r1.y), bfhi(r1.y)};
    float sq = 0.f;
#pragma unroll
    for (int j = 0; j < 16; ++j) sq += nv[j] * nv[j];
#pragma unroll
    for (int j = 0; j < 4; ++j) sq += x1[j] * x1[j] + x2[j] * x2[j];
    sq += __shfl_xor(sq, 1); sq += __shfl_xor(sq, 2); sq += __shfl_xor(sq, 4);
    const float rs = __builtin_amdgcn_rsqf(sq * (1.f / 192.f) + EPS) * scale;
#pragma unroll
    for (int j = 0; j < 16; ++j) nv[j] *= rs * gain[16 * tt + j];
    float o1[4], o2[4];
#pragma unroll
    for (int j = 0; j < 4; ++j) { const float a = x1[j] * rs * gain[128 + 4 * tt + j], bq = x2[j] * rs * gain[160 + 4 * tt + j]; o1[j] = a * c4[j] - bq * s4[j]; o2[j] = bq * c4[j] + a * s4[j]; }
    u32x4 w0, w1; w0.x = pk2(nv[0], nv[1]); w0.y = pk2(nv[2], nv[3]); w0.z = pk2(nv[4], nv[5]); w0.w = pk2(nv[6], nv[7]);
    w1.x = pk2(nv[8], nv[9]); w1.y = pk2(nv[10], nv[11]); w1.z = pk2(nv[12], nv[13]); w1.w = pk2(nv[14], nv[15]);
    *(u32x4*)(dst + 16 * tt) = w0; *(u32x4*)(dst + 16 * tt + 8) = w1;
    u32x2 v0, v1; v0.x = pk2(o1[0], o1[1]); v0.y = pk2(o1[2], o1[3]); v1.x = pk2(o2[0], o2[1]); v1.y = pk2(o2[2], o2[3]);
    *(u32x2*)(dst + 128 + 4 * tt) = v0; *(u32x2*)(dst + 160 + 4 * tt) = v1;
}
__device__ __forceinline__ void mla_finalize(const Params& P, int wave) {
    const int lane = lane_id_asm();
    unsigned char* ws = P.ws;
    bf16_t* Q = (bf16_t*)(ws + WS_R + R_Q); bf16_t* KV = (bf16_t*)(ws + WS_R + R_KV); const bf16_t* CQ = (const bf16_t*)(ws + WS_R + R_CQKV);
    const float* cM = (const float*)(ws + WS_ROPE_M); const float* sM = cM + 4096 * 32;
    const float* qg = (const float*)(ws + WS_SMALL) + 2048; const float* kg = qg + 192;
    const int hh = lane >> 3, tt = lane & 7;
    const float qscale = 0.07216878364870322f * 1.4426950408889634f;
    const int gw = blockIdx.x * NWAVES + wave, NGW = gridDim.x * NWAVES;
#pragma unroll 1
    for (int r = gw; r < MT; r += 2 * NGW) {
        const int r2 = r + NGW; const bool two = r2 < MT;
        FinRow A, B;
        fin_load(A, Q, KV, CQ, cM, sM, r, hh, tt);
        fin_load(B, Q, KV, CQ, cM, sM, two ? r2 : r, hh, tt);
        fin_one(KV + (size_t)r * 2560 + hh * 320, A.kn0, A.kn1, A.kr0, A.kr1, A.c4, A.s4, kg, tt, 1.f);
        if (two) {
            fin_one(KV + (size_t)r2 * 2560 + hh * 320, B.kn0, B.kn1, B.kr0, B.kr1, B.c4, B.s4, kg, tt, 1.f);
        }
    }
}

typedef float f32x16 __attribute__((ext_vector_type(16)));
typedef short v4i16_t __attribute__((ext_vector_type(4)));
__device__ __forceinline__ bf16x8 tr_pair(const LAS unsigned char* p0, const LAS unsigned char* p1) {
    const v4i16_t lo = __builtin_amdgcn_ds_read_tr16_b64_v4i16((LAS v4i16_t*)p0), hi = __builtin_amdgcn_ds_read_tr16_b64_v4i16((LAS v4i16_t*)p1);
    return (bf16x8){lo[0], lo[1], lo[2], lo[3], hi[0], hi[1], hi[2], hi[3]};
}
__device__ __forceinline__ bf16x8 pack8bf(float a0, float a1, float a2, float a3, float a4, float a5, float a6, float a7) {
    u32x4 w; w.x = cvt_pk_bf16(a0, a1); w.y = cvt_pk_bf16(a2, a3); w.z = cvt_pk_bf16(a4, a5); w.w = cvt_pk_bf16(a6, a7); return __builtin_bit_cast(bf16x8, w);
}
typedef short s16x4 __attribute__((ext_vector_type(4)));
#define TR_READ(dst, addr, off) asm volatile("ds_read_b64_tr_b16 %0, %1 offset:%c2" : "=v"(dst) : "v"(addr), "i"(off) : "memory")
#define TR_WAIT4(n, a, b, c, d) asm volatile("s_waitcnt lgkmcnt(" #n ")" : "+v"(a), "+v"(b), "+v"(c), "+v"(d) :: "memory")
__device__ __forceinline__ void att_qk_sm(const LAS unsigned char* kb, int klane, const bf16x8 (&qf)[12], f32x16 (&o)[4], float& mrun, float& lrun, bf16x8 (&pb)[4]) {
    constexpr int KP = 400;
    f32x16 s0, s1;
#pragma unroll
    for (int i = 0; i < 16; ++i) { s0[i] = 0.f; s1[i] = 0.f; }
    bf16x8 ka[3][2];
#pragma unroll
    for (int g = 0; g < 2; ++g) { ka[g][0] = *(const LAS bf16x8*)(kb + klane + g * 32); ka[g][1] = *(const LAS bf16x8*)(kb + klane + 32 * KP + g * 32); }
#pragma unroll
    for (int g = 0; g < 12; ++g) {
        if (g < 10) { ka[(g + 2) % 3][0] = *(const LAS bf16x8*)(kb + klane + (g + 2) * 32); ka[(g + 2) % 3][1] = *(const LAS bf16x8*)(kb + klane + 32 * KP + (g + 2) * 32); }
        __builtin_amdgcn_sched_barrier(0);
        s0 = __builtin_amdgcn_mfma_f32_32x32x16_bf16(ka[g % 3][0], qf[g], s0, 0, 0, 0);
        s1 = __builtin_amdgcn_mfma_f32_32x32x16_bf16(ka[g % 3][1], qf[g], s1, 0, 0, 0);
        __builtin_amdgcn_sched_barrier(0);
    }
    float mx = fmaxf(s0[0], s1[0]);
#pragma unroll
    for (int i = 1; i < 16; ++i) asm("v_max3_f32 %0, %1, %2, %3" : "=v"(mx) : "v"(mx), "v"(s0[i]), "v"(s1[i]));
    { const auto rr = __builtin_amdgcn_permlane32_swap(__float_as_uint(mx), __float_as_uint(mx), false, false);
      mx = fmaxf(__uint_as_float(rr[0]), __uint_as_float(rr[1])); }
    if (!__all(mx - mrun <= 8.0f)) {
        const float mn = fmaxf(mrun, mx), al = __builtin_amdgcn_exp2f(mrun - mn);
        mrun = mn; lrun *= al;
#pragma unroll
        for (int d = 0; d < 4; ++d) o[d] = o[d] * al;
    }
    float ps = 0.f;
#pragma unroll
    for (int i = 0; i < 16; ++i) { s0[i] = __builtin_amdgcn_exp2f(s0[i] - mrun); s1[i] = __builtin_amdgcn_exp2f(s1[i] - mrun); ps += s0[i] + s1[i]; }
    lrun += ps;
    pb[0] = pack8bf(s0[0], s0[1], s0[2], s0[3], s0[4], s0[5], s0[6], s0[7]);
    pb[1] = pack8bf(s0[8], s0[9], s0[10], s0[11], s0[12], s0[13], s0[14], s0[15]);
    pb[2] = pack8bf(s1[0], s1[1], s1[2], s1[3], s1[4], s1[5], s1[6], s1[7]);
    pb[3] = pack8bf(s1[8], s1[9], s1[10], s1[11], s1[12], s1[13], s1[14], s1[15]);
    __builtin_amdgcn_sched_barrier(0);
}
__device__ __forceinline__ void att_pv(const LAS unsigned char* kb, int vlane, const bf16x8 (&pb)[4], f32x16 (&o)[4]) {
    constexpr int VP = 320;
    s16x4 vlo[2][4], vhi[2][4];
    const unsigned vaddr = (unsigned)(unsigned long)(kb + vlane);
#pragma unroll
    for (int d = 0; d < 4; ++d) { TR_READ(vlo[0][d], vaddr, d * 64); TR_READ(vhi[0][d], vaddr, 8 * VP + d * 64); }
#pragma unroll
    for (int ks = 0; ks < 4; ++ks) {
        if (ks < 3) {
#pragma unroll
            for (int d = 0; d < 4; ++d) { TR_READ(vlo[(ks + 1) & 1][d], vaddr, ((ks + 1) * 16) * VP + d * 64); TR_READ(vhi[(ks + 1) & 1][d], vaddr, ((ks + 1) * 16 + 8) * VP + d * 64); }
            TR_WAIT4(8, vlo[ks & 1][0], vlo[ks & 1][1], vlo[ks & 1][2], vlo[ks & 1][3]); TR_WAIT4(8, vhi[ks & 1][0], vhi[ks & 1][1], vhi[ks & 1][2], vhi[ks & 1][3]);
        } else {
            TR_WAIT4(0, vlo[ks & 1][0], vlo[ks & 1][1], vlo[ks & 1][2], vlo[ks & 1][3]); TR_WAIT4(0, vhi[ks & 1][0], vhi[ks & 1][1], vhi[ks & 1][2], vhi[ks & 1][3]);
        }
        __builtin_amdgcn_sched_barrier(0);
#pragma unroll
        for (int d = 0; d < 4; ++d) { const bf16x8 a = __builtin_shufflevector(vlo[ks & 1][d], vhi[ks & 1][d], 0, 1, 2, 3, 4, 5, 6, 7);
            o[d] = __builtin_amdgcn_mfma_f32_32x32x16_bf16(a, pb[ks], o[d], 0, 0, 0); }
        __builtin_amdgcn_sched_barrier(0);
    }
}
__device__ __forceinline__ void att_mfma(const Params& P, LAS unsigned char* lds, int wave) {
    unsigned char* ws = P.ws;
    const bf16_t* Q = (const bf16_t*)(ws + WS_R + R_Q); const bf16_t* KV = (const bf16_t*)(ws + WS_R + R_KV); bf16_t* O = (bf16_t*)(ws + WS_R + R_O);
    const int lane = lane_id_asm(), q32 = lane & 31, hf = lane >> 5;
    constexpr int KP = 400, VP = 320, KB = 64 * KP, BUF = KB + 64 * VP;
    unsigned goff[6];
#pragma unroll
    for (int i = 0; i < 6; ++i) { int q = wave + 8 * i; q = q > 44 ? 44 : q; int p = q * 64 + lane;
        if (q < 25) { const int r = p / 25; int c = p % 25; c = c == 24 ? 0 : c; goff[i] = (unsigned)(r * 5120 + c * 16); }
        else { p -= 1600; const int r = p / 20; int c = p % 20; c = c >= 16 ? 0 : c; goff[i] = (unsigned)(r * 5120 + 384 + c * 16); } }
#define ATT_ISSUE(tilebase, bufbase) do { const unsigned char* _tb = (tilebase); asm volatile("" : "+s"(_tb)); _Pragma("unroll") for (int _i = 0; _i < 6; ++_i) { int _q = wave + 8 * _i; _q = _q > 44 ? 44 : _q; \
        __builtin_amdgcn_global_load_lds((const unsigned*)(_tb + goff[_i]), (LAS unsigned*)((bufbase) + _q * 1024), 16, 0, 0); } } while (0)
#define ATT_BAR() do { asm volatile("s_waitcnt vmcnt(0) lgkmcnt(0)" ::: "memory"); __builtin_amdgcn_s_barrier(); asm volatile("" ::: "memory"); } while (0)
    const int i16 = lane & 15, blk = (lane >> 4) & 1;
    const int vlane = KB + ((i16 >> 2) + 4 * hf) * VP + (16 * blk + 4 * (i16 & 3)) * 2;
    const int klane = q32 * KP + hf * 16;
    const bool roleA = wave < 4;
    const int w4 = wave & 3;
    for (int u = blockIdx.x; u < 1024; u += gridDim.x) {
        const int bh = u & 63, r = u >> 6, kk = r >> 2, j4 = r & 3;
        const int qb = kk == 0 ? j4 : (kk == 1 ? 15 - j4 : (kk == 2 ? 4 + j4 : 11 - j4));
        const int b = bh >> 3, hh = bh & 7;
        const int ntile = 4 * qb + 4, my_last = 4 * qb + w4;
        const size_t qrow_g = (size_t)b * SEQ + qb * 256 + w4 * 64 + (wave >> 2) * 32 + q32;
        const unsigned char* kvb = (const unsigned char*)(KV + (size_t)b * SEQ * 2560 + hh * 320);
        ATT_ISSUE(kvb, lds);
        bf16x8 qf[12];
        { const bf16_t* qp = Q + qrow_g * 1536 + hh * 192 + hf * 8;
#pragma unroll
          for (int ks = 0; ks < 12; ++ks) qf[ks] = *(const bf16x8*)(qp + ks * 16); }
        f32x16 o[4];
#pragma unroll
        for (int d = 0; d < 4; ++d)
#pragma unroll
            for (int i = 0; i < 16; ++i) o[d][i] = 0.f;
        float mrun = -1e30f, lrun = 0.f;
        bf16x8 pb[4];
#pragma unroll
        for (int i = 0; i < 4; ++i) pb[i] = (bf16x8){0, 0, 0, 0, 0, 0, 0, 0};
        ATT_BAR();
#pragma unroll
        for (int ks = 0; ks < 12; ++ks) asm volatile("" : "+v"(qf[ks]));
        {
            float qv[12][8]; float sq = 0.f;
#pragma unroll
            for (int ks = 0; ks < 12; ++ks)
#pragma unroll
                for (int e = 0; e < 8; ++e) { qv[ks][e] = bf2f((unsigned short)qf[ks][e]); sq += qv[ks][e] * qv[ks][e]; }
            { const auto rr = __builtin_amdgcn_permlane32_swap(__float_as_uint(sq), __float_as_uint(sq), false, false);
              sq = __uint_as_float(rr[0]) + __uint_as_float(rr[1]); }
            const float rs = __builtin_amdgcn_rsqf(sq * (1.f / 192.f) + EPS) * (0.07216878364870322f * 1.4426950408889634f);
            const float* qg = (const float*)(ws + WS_SMALL) + 2048 + 8 * hf;
            const int spos = (int)(qrow_g & (SEQ - 1));
            const float* cM = (const float*)(ws + WS_ROPE_M) + spos * 32 + 8 * hf; const float* sM = cM + 4096 * 32;
#pragma unroll
            for (int ks = 0; ks < 12; ++ks) { const f32x4 g0 = *(const f32x4*)(qg + 16 * ks), g1 = *(const f32x4*)(qg + 16 * ks + 4);
#pragma unroll
                for (int e = 0; e < 4; ++e) { qv[ks][e] *= rs * g0[e]; qv[ks][4 + e] *= rs * g1[e]; } }
#pragma unroll
            for (int k2 = 0; k2 < 2; ++k2) {
                const f32x4 c0 = *(const f32x4*)(cM + 16 * k2), c1 = *(const f32x4*)(cM + 16 * k2 + 4), s0 = *(const f32x4*)(sM + 16 * k2), s1 = *(const f32x4*)(sM + 16 * k2 + 4);
#pragma unroll
                for (int e = 0; e < 8; ++e) { const float cc = e < 4 ? c0[e & 3] : c1[e & 3], ss = e < 4 ? s0[e & 3] : s1[e & 3];
                    const float a = qv[8 + k2][e], bq = qv[10 + k2][e]; qv[8 + k2][e] = a * cc - bq * ss; qv[10 + k2][e] = bq * cc + a * ss; }
            }
#pragma unroll
            for (int ks = 0; ks < 12; ++ks) qf[ks] = pack8bf(qv[ks][0], qv[ks][1], qv[ks][2], qv[ks][3], qv[ks][4], qv[ks][5], qv[ks][6], qv[ks][7]);
        }
        int bcur = 0, bprev = 2, bnext = 1;
#pragma unroll 1
        for (int kt = 0; kt < ntile; ++kt) {
            if (kt + 1 < ntile) ATT_ISSUE(kvb + (size_t)(kt + 1) * 327680, lds + bnext * BUF);
            if (!roleA && kt >= 1 && kt - 1 <= my_last) att_pv(lds + bprev * BUF, vlane, pb, o);
            if (kt <= my_last) att_qk_sm(lds + bcur * BUF, klane, qf, o, mrun, lrun, pb);
            if (roleA && kt <= my_last) att_pv(lds + bcur * BUF, vlane, pb, o);
            ATT_BAR();
            bprev = bcur; bcur = bnext; bnext = bnext == 2 ? 0 : bnext + 1;
        }
        if (!roleA && ntile - 1 <= my_last) att_pv(lds + bprev * BUF, vlane, pb, o);
        ATT_BAR();
        const float lt = lrun + __shfl_xor(lrun, 32), il = 1.f / lt;
        bf16_t* op = O + qrow_g * 1024 + hh * 128 + 4 * hf;
#pragma unroll
        for (int d = 0; d < 4; ++d)
#pragma unroll
            for (int j = 0; j < 4; ++j) { u32x2 w; w.x = cvt_pk_bf16(o[d][4 * j] * il, o[d][4 * j + 1] * il); w.y = cvt_pk_bf16(o[d][4 * j + 2] * il, o[d][4 * j + 3] * il);
                *(u32x2*)(op + d * 32 + 8 * j) = w; }
    }
#undef ATT_ISSUE
#undef ATT_BAR
}

__device__ __forceinline__ void ret_mfma(const Params& P, LAS unsigned char* lds, int wave) {
    unsigned char* ws = P.ws;
    const bf16_t* QK = (const bf16_t*)(ws + WS_R + R_QK); bf16_t* V = (bf16_t*)(ws + WS_R + R_V); float* rssq = (float*)(ws + WS_RSSQ);
    constexpr int QP = 528, VP = 192, SP = 144;
    constexpr int Q_OFF = 0, K_OFF = 33792, V_OFF = 67584, VS_OFF = 79872, ST_OFF = 92160, S_OFF = 125952;
    const int lane = lane_id_asm(), t = wave * 64 + lane, q32 = lane & 31, hf = lane >> 5, i16 = lane & 15, blk = (lane >> 4) & 1;
    const int trrow = 8 * hf + (i16 >> 2), trcol = (16 * blk + 4 * (i16 & 3)) * 2;
    for (int unit = blockIdx.x; unit < 256; unit += gridDim.x) {
        const int xcd_ = unit & 7, idx_ = unit >> 3, bh = xcd_ * 4 + (idx_ >> 3), slice = idx_ & 7, b = bh >> 2, hh = bh & 3;
        const float gam = 1.f - exp2f(-5.f - (float)hh), lg = log2f(gam), g64 = exp2f(lg * 64.f);
        for (int i = t; i < 33792 / 16; i += NTHREADS) *(LAS u32x4*)(lds + ST_OFF + i * 16) = (u32x4){0u, 0u, 0u, 0u};
        f32x16 st[2];
#pragma unroll
        for (int a = 0; a < 2; ++a)
#pragma unroll
            for (int i = 0; i < 16; ++i) st[a][i] = 0.f;
        const size_t rb = (size_t)b * SEQ;
        float dec[16];
        { const int mblk = (wave & 3) >> 1, nblk = wave & 1, n = nblk * 32 + q32;
#pragma unroll
          for (int i = 0; i < 16; ++i) { const int mm = mblk * 32 + 8 * (i >> 2) + 4 * hf + (i & 3); const int dist = n > mm ? n - mm : mm - n;
              dec[i] = wave < 4 ? __builtin_amdgcn_exp2f(lg * (float)(dist - (63 - mm))) : __builtin_amdgcn_exp2f(lg * (float)(n + 1)); } }
        u32x4 pq[4], pkk[4], pvv;
        const int vr = t >> 3, vc = t & 7;
#pragma unroll
        for (int i = 0; i < 4; ++i) { const int id = t + 512 * i, r = id >> 5, ch = id & 31;
            pq[i] = *(const u32x4*)(QK + (rb + r) * 2048 + hh * 256 + ch * 8); pkk[i] = *(const u32x4*)(QK + (rb + r) * 2048 + 1024 + hh * 256 + ch * 8); }
        pvv = *(const u32x4*)(V + (rb + vr) * 2048 + hh * 512 + slice * 64 + vc * 8);
#pragma unroll 1
        for (int c = 0; c < 64; ++c) {
#pragma unroll
            for (int i = 0; i < 4; ++i) { const int id = t + 512 * i, r = id >> 5, ch = id & 31;
                *(LAS u32x4*)(lds + Q_OFF + r * QP + ch * 16) = pq[i]; *(LAS u32x4*)(lds + K_OFF + r * QP + ch * 16) = pkk[i]; }
            *(LAS u32x4*)(lds + V_OFF + vr * VP + vc * 16) = pvv;
            __syncthreads();
            if (c + 1 < 64) { const size_t r1 = rb + (size_t)(c + 1) * 64;
#pragma unroll
                for (int i = 0; i < 4; ++i) { const int id = t + 512 * i, r = id >> 5, ch = id & 31;
                    pq[i] = *(const u32x4*)(QK + (r1 + r) * 2048 + hh * 256 + ch * 8); pkk[i] = *(const u32x4*)(QK + (r1 + r) * 2048 + 1024 + hh * 256 + ch * 8); }
                pvv = *(const u32x4*)(V + (r1 + vr) * 2048 + hh * 512 + slice * 64 + vc * 8); }
            const size_t r0 = rb + (size_t)c * 64;
            f32x16 acc;
#pragma unroll
            for (int i = 0; i < 16; ++i) acc[i] = 0.f;
            if (wave < 4) {
                const int mblk = wave >> 1, nblk = wave & 1, n = nblk * 32 + q32;
#pragma unroll 4
                for (int ks = 0; ks < 16; ++ks) {
                    const bf16x8 a = *(const LAS bf16x8*)(lds + K_OFF + (mblk * 32 + q32) * QP + ks * 32 + hf * 16);
                    const bf16x8 bq = *(const LAS bf16x8*)(lds + Q_OFF + n * QP + ks * 32 + hf * 16);
                    acc = __builtin_amdgcn_mfma_f32_32x32x16_bf16(a, bq, acc, 0, 0, 0);
                }
#pragma unroll
                for (int i = 0; i < 16; ++i) acc[i] *= dec[i];
#pragma unroll
                for (int j = 0; j < 4; ++j) { u32x2 w; w.x = cvt_pk_bf16(acc[4 * j], acc[4 * j + 1]); w.y = cvt_pk_bf16(acc[4 * j + 2], acc[4 * j + 3]);
                    *(LAS u32x2*)(lds + S_OFF + n * SP + (mblk * 32 + 8 * j + 4 * hf) * 2) = w; }
            } else {
                const int w4 = wave - 4, dvblk = w4 >> 1, nblk = w4 & 1, n = nblk * 32 + q32;
#pragma unroll 4
                for (int ks = 0; ks < 16; ++ks) {
                    const bf16x8 a = *(const LAS bf16x8*)(lds + ST_OFF + (dvblk * 32 + q32) * QP + ks * 32 + hf * 16);
                    const bf16x8 bq = *(const LAS bf16x8*)(lds + Q_OFF + n * QP + ks * 32 + hf * 16);
                    acc = __builtin_amdgcn_mfma_f32_32x32x16_bf16(a, bq, acc, 0, 0, 0);
                }
                acc = acc * dec[0];
            }
            __syncthreads();
            {
#pragma unroll
                for (int a = 0; a < 2; ++a) st[a] = st[a] * g64;
#pragma unroll
                for (int ks = 0; ks < 4; ++ks) {
                    bf16x8 av[2], bk;
#pragma unroll
                    for (int vb = 0; vb < 2; ++vb) { const LAS unsigned char* p = lds + V_OFF + (16 * ks + trrow) * VP + vb * 64 + trcol; av[vb] = tr_pair(p, p + 4 * VP); }
                    { const LAS unsigned char* p = lds + K_OFF + (16 * ks + trrow) * QP + wave * 64 + trcol; bk = tr_pair(p, p + 4 * QP); }
#pragma unroll
                    for (int vb = 0; vb < 2; ++vb) st[vb] = __builtin_amdgcn_mfma_f32_32x32x16_bf16(av[vb], bk, st[vb], 0, 0, 0);
                }
#pragma unroll
                for (int vb = 0; vb < 2; ++vb)
#pragma unroll
                    for (int i = 0; i < 16; ++i) { const int dv = vb * 32 + 8 * (i >> 2) + 4 * hf + (i & 3);
                        *(LAS bf16_t*)(lds + ST_OFF + dv * QP + (wave * 32 + q32) * 2) = (bf16_t)(cvt_pk_bf16(st[vb][i], 0.f) & 0xffffu); }
            }
            if (wave >= 4) {
                const int w4 = wave - 4, dvblk = w4 >> 1, nblk = w4 & 1, n = nblk * 32 + q32;
#pragma unroll
                for (int ks = 0; ks < 4; ++ks) {
                    const LAS unsigned char* p = lds + V_OFF + (16 * ks + trrow) * VP + dvblk * 64 + trcol;
                    const bf16x8 a = tr_pair(p, p + 4 * VP);
                    const bf16x8 bs = *(const LAS bf16x8*)(lds + S_OFF + n * SP + (16 * ks + 8 * hf) * 2);
                    acc = __builtin_amdgcn_mfma_f32_32x32x16_bf16(a, bs, acc, 0, 0, 0);
                }
                float sq = 0.f;
#pragma unroll
                for (int i = 0; i < 16; ++i) sq += acc[i] * acc[i];
                sq += __shfl_xor(sq, 32);
                if (hf == 0) rssq[(r0 + n) * 64 + hh * 16 + slice * 2 + dvblk] = sq;
                bf16_t* op = V + (r0 + n) * 2048 + hh * 512 + slice * 64 + dvblk * 32 + 4 * hf;
#pragma unroll
                for (int j = 0; j < 4; ++j) { u32x2 w; w.x = cvt_pk_bf16(acc[4 * j], acc[4 * j + 1]); w.y = cvt_pk_bf16(acc[4 * j + 2], acc[4 * j + 3]); *(u32x2*)(op + 8 * j) = w; }
            }
            __syncthreads();
        }
    }
}

#define XB_TMO      128
#define XB_XCNT(j)  (256  + 64 * (j))
#define XB_XSUB(j)  (1280 + 64 * (j))
#define XB_XGEN(j)  (2304 + 64 * (j))
#define XB_TOP      3328
#define XB_TOPGEN   3392
#define XCD_BAR_WORDS 3456
#define XB_SPIN_CAP (1u << 18)

__device__ __forceinline__ unsigned xb_ld(unsigned* p)              { return __hip_atomic_load(p, __ATOMIC_RELAXED, __HIP_MEMORY_SCOPE_AGENT); }
__device__ __forceinline__ unsigned xb_add(unsigned* p, unsigned v) { return __hip_atomic_fetch_add(p, v, __ATOMIC_RELAXED, __HIP_MEMORY_SCOPE_AGENT); }
__device__ __forceinline__ unsigned xb_xcc_id() { return (unsigned)__builtin_amdgcn_s_getreg((3 << 11) | 20) & 0xFu; }
#define XB_SPIN(cond, bar) do { unsigned _sp = 0; while (cond) { __builtin_amdgcn_s_sleep(1); \
    if ((++_sp & 255u) == 0u) { if (xb_ld(&(bar)[XB_TMO])) break; if (_sp > XB_SPIN_CAP) { atomicAdd(&(bar)[XB_TMO], 1u); break; } } } } while (0)

struct XcdBarrier {
    unsigned* bar; unsigned x;
    volatile LAS unsigned* st;
};

__device__ __forceinline__ XcdBarrier xcd_barrier_post(unsigned* bar, volatile LAS unsigned* st) {
    XcdBarrier b; b.bar = bar; b.x = xb_xcc_id(); b.st = st;
    if (threadIdx.x == 0) (void)xb_add(&bar[XB_XCNT(b.x)], 1u);
    return b;
}
__device__ __forceinline__ void xcd_barrier_complete(unsigned* bar, unsigned x, unsigned& nloc, unsigned& nx) {
    const unsigned G = gridDim.x * gridDim.y * gridDim.z;
    unsigned sum, cnt, mine, sp = 0u;
    for (;;) {
        sum = 0u; cnt = 0u; mine = 0u;
#pragma unroll
        for (unsigned j = 0; j < 16; ++j) { const unsigned c = xb_ld(&bar[XB_XCNT(j)]); sum += c; cnt += (c > 0u) ? 1u : 0u; mine = (j == x) ? c : mine; }
        if (sum == G) break;
        __builtin_amdgcn_s_sleep(1);
        if ((++sp & 255u) == 0u) { if (xb_ld(&bar[XB_TMO])) break; if (sp > XB_SPIN_CAP) { atomicAdd(&bar[XB_TMO], 1u); break; } }
    }
    nloc = mine > 0u ? mine : 1u; nx = cnt > 0u ? cnt : 1u;
}

__device__ __forceinline__ void xcd_barrier(const XcdBarrier& b) {
    asm volatile("s_waitcnt vmcnt(0)" ::: "memory");
    __syncthreads();
    if (threadIdx.x == 0) {
        unsigned* bar = b.bar;
        __builtin_amdgcn_s_waitcnt(0);
        unsigned nloc = b.st[0], nx = b.st[1];
        if (nloc == 0u) { xcd_barrier_complete(bar, b.x, nloc, nx); b.st[0] = nloc; b.st[1] = nx; }
        const unsigned old = xb_add(&bar[XB_XSUB(b.x)], 1u);
        const unsigned gen = old / nloc;
        if (old + 1u == (gen + 1u) * nloc) {
            __builtin_amdgcn_fence(__ATOMIC_RELEASE, "agent");
            asm volatile("s_waitcnt vmcnt(0)" ::: "memory");
            const unsigned og = xb_add(&bar[XB_TOP], 1u);
            const unsigned tg = og / nx;
            if (og + 1u == (tg + 1u) * nx) xb_add(&bar[XB_TOPGEN], 1u);
            else XB_SPIN(xb_ld(&bar[XB_TOPGEN]) == tg, bar);
            __builtin_amdgcn_fence(__ATOMIC_ACQUIRE, "agent");
            xb_add(&bar[XB_XGEN(b.x)], 1u);
            asm volatile("s_waitcnt vmcnt(0)" ::: "memory");
        } else {
            XB_SPIN(xb_ld(&bar[XB_XGEN(b.x)]) == gen, bar);
            __builtin_amdgcn_fence(__ATOMIC_ACQUIRE, "agent");
            asm volatile("s_waitcnt vmcnt(0)" ::: "memory");
        }
    }
    __syncthreads();
}

#ifndef PHMASK
#define PHMASK 0xFFFFFF
#endif
#define PH(n) if constexpr (((PHMASK) >> (n)) & 1)
#ifndef DUPMASK
#define DUPMASK 0
#endif
#define DUP(n) for (int rep_ = 0; rep_ < 1 + (((DUPMASK) >> (n)) & 1); ++rep_)
__global__ void __launch_bounds__(NTHREADS, 2) fwd_megakernel(Params P) {
    extern __shared__ __attribute__((aligned(16))) unsigned char lds_raw[];
    LAS unsigned char* lds = (LAS unsigned char*)lds_raw;
    cg::grid_group grid = cg::this_grid();
    const int wave = __builtin_amdgcn_readfirstlane(threadIdx.x >> 6);
    unsigned char* ws = P.ws;
    const int G = gridDim.x, c = blockIdx.x;
    bf16_t* Wb = (bf16_t*)(ws + WS_W);
    float* SSQ = (float*)(ws + WS_SSQ);
    bf16_t* hbA = (bf16_t*)(ws + WS_HBA);
    bf16_t* hbB = (bf16_t*)P.out;
    unsigned char* R = ws + WS_R;
    float* h = P.out;

    { volatile LAS unsigned* stw = (volatile LAS unsigned*)(lds + LDS_BYTES - 64); if (threadIdx.x < 2) stw[threadIdx.x] = 0u; __syncthreads(); }
    const XcdBarrier xbar = xcd_barrier_post((unsigned*)(ws + WS_BAR), (volatile LAS unsigned*)(lds + LDS_BYTES - 64));
    PH(0) prologue(P, lds, wave);
    if (P.out == nullptr) grid.sync();
    xcd_barrier(xbar);

    {
    PH(1) { pg8::Gemm g{hbA, Wb + W_RIN, MT, 4096, 1024, 1024}; pg8::StaticOrder S; S.init(MT, 4096, G, c);
      EpiRope E{(bf16_t*)(R + R_QK), (bf16_t*)(R + R_V), SSQ + SQ_MIX0 * MT, (const float*)(ws + WS_ROPE_R), (const float*)(ws + WS_ROPE_R) + 4096 * 128};
      pg8::gemm_phase(lds, g, S, E, wave); }
    xcd_barrier(xbar);
    PH(2) ret_mfma(P, lds, wave);
    xcd_barrier(xbar);
    }
    PH(3) { pg8::Gemm g{hbA, Wb + W_RIN + (size_t)4096 * 1024, MT, 2048, 1024, 1024}; pg8::StaticOrder S; S.init(MT, 2048, G, c, true);
      EpiGateY E{(bf16_t*)(R + R_V), SSQ + SQ_MIX0 * MT, (const float*)(ws + WS_RSSQ), (const float*)(ws + WS_SMALL)};
      pg8::gemm_phase(lds, g, S, E, wave); }
    xcd_barrier(xbar);
    PH(4) { pg8::Gemm g{(const bf16_t*)(R + R_V), Wb + W_ROUT, MT, 1024, 2048, 2048}; pg8::StaticOrder S; S.init(MT, 1024, G, c, true);
      EpiResidual E{hbA, hbA, SSQ + SQ_MLP0 * MT, nullptr};
      pg8::gemm_phase(lds, g, S, E, wave); }
    xcd_barrier(xbar);

    PH(11) { { pg8::Gemm g{hbA, Wb + W_1 + (size_t)0 * 4194304, MT, 4096, 1024, 1024}; pg8::StaticOrder S; S.init(MT, 4096, G, c);
      EpiScale<1, false> E{(bf16_t*)(R + R_HID), 4096, nullptr, 0.f, nullptr, nullptr};
      pg8::gemm_phase(lds, g, S, E, wave); } }
    xcd_barrier(xbar);
    PH(12) { pg8::Gemm g{(const bf16_t*)(R + R_HID), Wb + W_2 + (size_t)0 * 4194304, MT, 1024, 4096, 4096}; pg8::StaticOrder S; S.init(MT, 1024, G, c, true);
      EpiResidual E{hbA, hbA, SSQ + SQ_PLE0 * MT, SSQ + SQ_MLP0 * MT};
      pg8::gemm_phase(lds, g, S, E, wave); }
    xcd_barrier(xbar);
    PH(13) { pg8::Gemm g{(const bf16_t*)(ws + WS_PB) + (size_t)0 * MT * 256, Wb + W_P + (size_t)0 * 262144, MT, 1024, 256, 256}; pg8::StaticOrder S; S.init(MT, 1024, G, c);
      EpiPlainNP E{(bf16_t*)(R + R_PP)};
      pg8::gemm_phase(lds, g, S, E, wave); }
    PH(14) { pg8::Gemm g{hbA, Wb + W_G + (size_t)0 * 1048576, MT, 1024, 1024, 1024}; pg8::StaticOrder S; S.init(MT, 1024, G, c);
      EpiPle E{hbA, (const bf16_t*)(R + R_PP), SSQ + SQ_PLE0 * MT, hbB, SSQ + SQ_MIX1 * MT, nullptr};
      pg8::gemm_phase(lds, g, S, E, wave); }
    xcd_barrier(xbar);
    PH(5) { pg8::Gemm g{hbB, Wb + W_MIN, MT, 768, 1024, 1024}; pg8::StaticOrder S; S.init(MT, 768, G, c, true);
      EpiScale<0, true> E{(bf16_t*)(R + R_CQKV), 768, SSQ + SQ_MIX1 * MT, 1.f / 1024.f, SSQ + SQ_CQ * MT, SSQ + SQ_CKV * MT};
      pg8::gemm_phase(lds, g, S, E, wave); }
    xcd_barrier(xbar);
    PH(6) { pg8::Gemm g{(const bf16_t*)(R + R_CQKV), Wb + W_UQ, MT, 1536, 384, 768}; pg8::StaticOrder S; S.init(MT, 1536, G, c);
      EpiScale<0, false> E{(bf16_t*)(R + R_Q), 1536, nullptr, 0.f, nullptr, nullptr};
      pg8::gemm_phase(lds, g, S, E, wave); }
    PH(7) { pg8::Gemm g{(const bf16_t*)(R + R_CQKV) + 384, Wb + W_UKV, MT, 2560, 256, 768}; pg8::StaticOrder S; S.init(MT, 2560, G, c);
      EpiScale<0, false> E{(bf16_t*)(R + R_KV), 2560, SSQ + SQ_CKV * MT, 1.f / 256.f, nullptr, nullptr};
      pg8::gemm_phase(lds, g, S, E, wave); }
    xcd_barrier(xbar);
    PH(8) mla_finalize(P, wave);
    xcd_barrier(xbar);
    PH(9) att_mfma(P, lds, wave);
    xcd_barrier(xbar);
    PH(10) { pg8::Gemm g{(const bf16_t*)(R + R_O), Wb + W_MOUT, MT, 1024, 1024, 1024}; pg8::StaticOrder S; S.init(MT, 1024, G, c);
      EpiResidual E{hbB, hbA, SSQ + SQ_MLP1 * MT, nullptr};
      pg8::gemm_phase(lds, g, S, E, wave); }
    xcd_barrier(xbar);
    PH(11) { pg8::Gemm g{hbA, Wb + W_1 + (size_t)1 * 4194304, MT, 4096, 1024, 1024}; pg8::StaticOrder S; S.init(MT, 4096, G, c);
      EpiScale<1, false> E{(bf16_t*)(R + R_HID), 4096, nullptr, 0.f, nullptr, nullptr};
      pg8::gemm_phase(lds, g, S, E, wave); }
    xcd_barrier(xbar);
    PH(12) { pg8::Gemm g{(const bf16_t*)(R + R_HID), Wb + W_2 + (size_t)1 * 4194304, MT, 1024, 4096, 4096}; pg8::StaticOrder S; S.init(MT, 1024, G, c, true);
      EpiResidual E{hbA, hbA, SSQ + SQ_PLE1 * MT, SSQ + SQ_MLP1 * MT};
      pg8::gemm_phase(lds, g, S, E, wave); }
    xcd_barrier(xbar);
    PH(13) { pg8::Gemm g{(const bf16_t*)(ws + WS_PB) + (size_t)1 * MT * 256, Wb + W_P + (size_t)1 * 262144, MT, 1024, 256, 256}; pg8::StaticOrder S; S.init(MT, 1024, G, c);
      EpiPlainNP E{(bf16_t*)(R + R_PP)};
      pg8::gemm_phase(lds, g, S, E, wave); }
    PH(14) { pg8::Gemm g{hbA, Wb + W_G + (size_t)1 * 1048576, MT, 1024, 1024, 1024}; pg8::StaticOrder S; S.init(MT, 1024, G, c);
      EpiPle E{hbA, (const bf16_t*)(R + R_PP), SSQ + SQ_PLE1 * MT, nullptr, nullptr, h};
      pg8::gemm_phase(lds, g, S, E, wave); }
#ifdef SYNCPROBE
    for (int i_ = 0; i_ < 8; ++i_) xcd_barrier(xbar);
#endif
}

extern "C" void kernel_launch(void* const* d_in, const int* in_sizes, int n_in, void* d_out, int out_size, void* d_ws, size_t ws_size, hipStream_t stream) {
    static int grid_blocks = 0;
    if (grid_blocks == 0) {
        if (n_in != 20 || out_size != MT * DM || ws_size < WS_END) { fprintf(stderr, "kernel_launch: unexpected shapes (n_in %d out %d ws %zu)\n", n_in, out_size, ws_size); grid_blocks = -1; return; }
        int dev = 0, cus = 0, per_cu = 0;
        hipGetDevice(&dev);
        hipDeviceGetAttribute(&cus, hipDeviceAttributeMultiprocessorCount, dev);
        if (hipFuncSetAttribute((const void*)fwd_megakernel, hipFuncAttributeMaxDynamicSharedMemorySize, LDS_BYTES) != hipSuccess) { fprintf(stderr, "kernel_launch: hipFuncSetAttribute failed\n"); grid_blocks = -1; return; }
        hipOccupancyMaxActiveBlocksPerMultiprocessor(&per_cu, (const void*)fwd_megakernel, NTHREADS, LDS_BYTES);
        if (per_cu < 1) { fprintf(stderr, "kernel_launch: occupancy query says %d blocks per CU\n", per_cu); grid_blocks = -1; return; }
        grid_blocks = cus * per_cu;
    }
    if (grid_blocks < 0) return;
    if (hipMemsetAsync((char*)d_ws + WS_BAR, 0, 16384, stream) != hipSuccess) { fprintf(stderr, "kernel_launch: memset failed\n"); return; }
    Params p{};
    for (int i = 0; i < 20; ++i) p.in[i] = (const float*)d_in[i];
    p.out = (float*)d_out; p.ws = (unsigned char*)d_ws;
    void* args[] = {&p};
    hipError_t e = hipLaunchCooperativeKernel((const void*)fwd_megakernel, dim3(grid_blocks), dim3(NTHREADS), args, LDS_BYTES, stream);
    if (e != hipSuccess) fprintf(stderr, "cooperative launch failed: %s (grid %d)\n", hipGetErrorString(e), grid_blocks);
}
```
